# Optimizing an MI355X kernel written in HIP

```python
import jax
import jax.numpy as jnp
from jax import lax
import numpy as np

D_MODEL = 1024
BATCH = 16
SEQ = 4096
DEPTH = 4

GRID_W = 64
CTX_LEN = 256
N_MIXERS = 3
ALPHA = (2.0 * DEPTH) ** 0.25
BETA = (8.0 * DEPTH) ** -0.25
LN_EPS = 1e-5
RMS_EPS = 1e-6
ROPE_BASE = 10000.0

RET_HEADS = 4
RET_DK = D_MODEL // RET_HEADS
RET_DV = 2 * RET_DK
RET_QK = RET_HEADS * RET_DK
RET_VW = RET_HEADS * RET_DV
RET_CHUNK = 128

MLA_HEADS = 8
MLA_Q_LORA = 3 * D_MODEL // 8
MLA_KV_LORA = D_MODEL // 4
MLA_NOPE = 128
MLA_ROPE = 64
MLA_V = 128
Q_BLOCK = 128

CONV_WIDTH = 3

MOE_GROUPS = 4
MOE_EXPERTS_PER_GROUP = 8
MOE_EXPERTS = MOE_GROUPS * MOE_EXPERTS_PER_GROUP
MOE_TOPK = 2
MOE_HIDDEN = D_MODEL // 2
MOE_BLOCK = 256

N_RET = (DEPTH + 2) // 3
N_MLA = (DEPTH + 1) // 3
N_CONV = DEPTH // 3

kernel_name = 'hybrid_retention_mla_shortconv_hmoe_dit'


def layer_norm(x, g, b):
    xf = x.astype(jnp.float32)
    mu = jnp.mean(xf, -1, keepdims=True)
    var = jnp.mean(jnp.square(xf - mu), -1, keepdims=True)
    y = (xf - mu) * lax.rsqrt(var + LN_EPS)
    return (y * g.astype(jnp.float32) + b.astype(jnp.float32)).astype(x.dtype)


def rms_norm(x, g):
    xf = x.astype(jnp.float32)
    y = xf * lax.rsqrt(jnp.mean(xf * xf, -1, keepdims=True) + RMS_EPS)
    return (y * g.astype(jnp.float32)).astype(x.dtype)


def modulate(h, shift, scale):
    return h * (1.0 + scale) + shift


def axial_rope_tables(n_tokens, dim):
    n_rows = n_tokens // GRID_W
    rows = jnp.repeat(jnp.arange(n_rows, dtype=jnp.float32), GRID_W)
    cols = jnp.tile(jnp.arange(GRID_W, dtype=jnp.float32), n_rows)
    quarter = dim // 4
    inv_freq = ROPE_BASE ** (-jnp.arange(quarter, dtype=jnp.float32) / quarter)
    ang = jnp.concatenate([rows[:, None] * inv_freq, cols[:, None] * inv_freq], axis=-1)
    return jnp.cos(ang), jnp.sin(ang)


def apply_rope(x, cos, sin):
    half = x.shape[-1] // 2
    cos = cos.astype(x.dtype)
    sin = sin.astype(x.dtype)
    x1, x2 = x[..., :half], x[..., half:]
    return jnp.concatenate([x1 * cos - x2 * sin, x1 * sin + x2 * cos], axis=-1)


def retention_scan(k, v, log_gamma, state0, q=None):
    b, h, t, _ = k.shape
    L = RET_CHUNK
    nc = t // L
    chunks = lambda a: jnp.moveaxis(a.reshape(b, h, nc, L, a.shape[-1]), 2, 0)
    idx = jnp.arange(L, dtype=jnp.float32)
    lg = log_gamma[:, None]
    k_dec = jnp.exp((L - 1.0 - idx) * lg)[..., None]
    c_dec = jnp.exp(L * lg)[..., None]

    def update(state, kc, vc):
        return state * c_dec + jnp.einsum('bhjd,bhje->bhde', kc * k_dec, vc)

    if q is None:
        final, _ = lax.scan(lambda st, kv: (update(st, kv[0], kv[1]), None), state0, (chunks(k), chunks(v)))
        return None, final
    rel = idx[:, None] - idx[None, :]
    intra = jnp.where(rel >= 0, jnp.exp(jnp.maximum(rel, 0.0) * lg[:, :, None]), 0.0)
    q_dec = jnp.exp((idx + 1.0) * lg)[..., None]

    def step(state, qkv):
        qc, kc, vc = qkv
        scores = jnp.einsum('bhid,bhjd->bhij', qc, kc) * intra
        out = jnp.einsum('bhij,bhje->bhie', scores, vc) + jnp.einsum('bhid,bhde->bhie', qc * q_dec, state)
        return update(state, kc, vc), out

    final, outs = lax.scan(step, state0, (chunks(q), chunks(k), chunks(v)))
    return jnp.moveaxis(outs, 0, 2).reshape(b, h, t, v.shape[-1]), final


def retention_mixer(u_ctx, u_lat, w_in, decay_logit, gn_g, w_out, need_ctx):
    b, s, _ = u_lat.shape
    w_q, w_k, w_v, w_g = jnp.split(w_in, [RET_QK, 2 * RET_QK, 2 * RET_QK + RET_VW], axis=1)

    def heads(z, dh):
        return z.reshape(b, -1, RET_HEADS, dh).transpose(0, 2, 1, 3).astype(jnp.float32)

    cos, sin = axial_rope_tables(s, RET_DK)
    q_l = apply_rope(heads(u_lat @ w_q, RET_DK), cos, sin)
    k_l = apply_rope(heads(u_lat @ w_k, RET_DK), cos, sin) * RET_DK ** -0.5
    v_l = heads(u_lat @ w_v, RET_DV)
    k_c = heads(u_ctx @ w_k, RET_DK) * RET_DK ** -0.5
    v_c = heads(u_ctx @ w_v, RET_DV)
    q_c = heads(u_ctx @ w_q, RET_DK) if need_ctx else None
    log_gamma = jax.nn.log_sigmoid(decay_logit.astype(jnp.float32))
    zero = jnp.zeros((b, RET_HEADS, RET_DK, RET_DV), jnp.float32)
    rev = lambda a: None if a is None else a[:, :, ::-1]
    o_cf, s_cf = retention_scan(k_c, v_c, log_gamma[0], zero, q_c)
    o_cb, s_cb = retention_scan(rev(k_c), rev(v_c), log_gamma[1], zero, rev(q_c))
    o_lf, _ = retention_scan(k_l, v_l, log_gamma[0], s_cf, q_l)
    o_lb, _ = retention_scan(rev(k_l), rev(v_l), log_gamma[1], s_cb, rev(q_l))

    def finish(o, u):
        mu = jnp.mean(o, -1, keepdims=True)
        var = jnp.mean(jnp.square(o - mu), -1, keepdims=True)
        on = ((o - mu) * lax.rsqrt(var + LN_EPS)).transpose(0, 2, 1, 3).reshape(b, -1, RET_VW)
        on = on * gn_g.astype(jnp.float32)
        return (jax.nn.silu(u @ w_g) * on.astype(u.dtype)) @ w_out

    y_lat = finish(o_lf + rev(o_lb), u_lat)
    y_ctx = finish(o_cf + rev(o_cb), u_ctx) if need_ctx else None
    return y_ctx, y_lat


def mla_mixer(u_ctx, u_lat, w_down, q_norm, kv_norm, w_uq, w_ukv, w_out, need_ctx):
    b, s, _ = u_lat.shape
    w_dq, w_dkv, w_kr = jnp.split(w_down, [MLA_Q_LORA, MLA_Q_LORA + MLA_KV_LORA], axis=1)
    cos, sin = axial_rope_tables(s, MLA_ROPE)
    scale = (MLA_NOPE + MLA_ROPE) ** -0.5

    def heads(z, dh):
        return z.reshape(b, -1, MLA_HEADS, dh).transpose(0, 2, 1, 3)

    def project_q(u):
        q = heads(rms_norm(u @ w_dq, q_norm) @ w_uq, MLA_NOPE + MLA_ROPE)
        return q[..., :MLA_NOPE], q[..., MLA_NOPE:]

    def project_kv(u):
        kv = heads(rms_norm(u @ w_dkv, kv_norm) @ w_ukv, MLA_NOPE + MLA_V)
        return kv[..., :MLA_NOPE], u @ w_kr, kv[..., MLA_NOPE:]

    def attend(qn, qr, kn, kr, v):
        sc = jnp.einsum('bhqd,bhkd->bhqk', qn, kn) + jnp.einsum('bhqd,bkd->bhqk', qr, kr)
        p = jax.nn.softmax(sc.astype(jnp.float32) * scale, axis=-1).astype(v.dtype)
        return jnp.einsum('bhqk,bhkd->bhqd', p, v)

    def merge(o):
        return o.transpose(0, 2, 1, 3).reshape(b, -1, MLA_HEADS * MLA_V) @ w_out

    qn_l, qr_l = project_q(u_lat)
    qr_l = apply_rope(qr_l, cos, sin)
    kn_l, kr_l, v_l = project_kv(u_lat)
    kr_l = apply_rope(kr_l, cos, sin)
    kn_c, kr_c, v_c = project_kv(u_ctx)
    kn_all = jnp.concatenate([kn_c, kn_l], axis=2)
    kr_all = jnp.concatenate([kr_c, kr_l], axis=1)
    v_all = jnp.concatenate([v_c, v_l], axis=2)
    nb = s // Q_BLOCK
    blocks = lambda a: jnp.moveaxis(a.reshape(b, MLA_HEADS, nb, Q_BLOCK, a.shape[-1]), 2, 0)
    o = lax.map(lambda qq: attend(qq[0], qq[1], kn_all, kr_all, v_all), (blocks(qn_l), blocks(qr_l)))
    y_lat = merge(jnp.moveaxis(o, 0, 2).reshape(b, MLA_HEADS, s, MLA_V))
    if not need_ctx:
        return None, y_lat
    qn_c, qr_c = project_q(u_ctx)
    y_ctx = merge(attend(qn_c, qr_c, kn_c, kr_c, v_c))
    return y_ctx, y_lat


def short_conv(h, w, bias):
    y = lax.conv_general_dilated(h, w[:, None, :].astype(h.dtype), window_strides=(1,),
                                 padding=((CONV_WIDTH // 2, CONV_WIDTH // 2),),
                                 dimension_numbers=('NWC', 'WIO', 'NWC'), feature_group_count=h.shape[-1])
    return y + bias


def conv_mixer(u, w_in, w, bias, w_out):
    gate_b, gate_c, h = jnp.split(u @ w_in, 3, axis=-1)
    return (gate_b * short_conv(gate_c * h, w, bias)) @ w_out


def hier_moe(t, w_group, b_group, w_expert, b_expert, w1, w3, w2):
    n, d = t.shape
    g_prob = jax.nn.softmax((t @ w_group).astype(jnp.float32) + b_group.astype(jnp.float32), axis=-1)
    g_p, g_idx = lax.top_k(g_prob, 1)
    e_logits = ((t @ w_expert).astype(jnp.float32) + b_expert.astype(jnp.float32)).reshape(n, MOE_GROUPS, MOE_EXPERTS_PER_GROUP)
    e_logits = jnp.take_along_axis(e_logits, g_idx[:, :, None], axis=1)[:, 0]
    e_p, e_idx = lax.top_k(jax.nn.softmax(e_logits, axis=-1), MOE_TOPK)
    gate = g_p * e_p / jnp.sum(e_p, -1, keepdims=True)
    expert = g_idx * MOE_EXPERTS_PER_GROUP + e_idx
    nk = n * MOE_TOPK
    flat_e = expert.reshape(nk)
    flat_tok = jnp.repeat(jnp.arange(n, dtype=jnp.int32), MOE_TOPK)
    flat_w = gate.reshape(nk)
    order = jnp.argsort(flat_e)
    se, stok, sw = flat_e[order], flat_tok[order], flat_w[order]
    counts = jnp.bincount(flat_e, length=MOE_EXPERTS)
    starts = jnp.cumsum(counts) - counts
    padded = (counts + MOE_BLOCK - 1) // MOE_BLOCK * MOE_BLOCK
    pad_ends = jnp.cumsum(padded)
    pad_starts = pad_ends - padded
    dest = pad_starts[se] + jnp.arange(nk) - starts[se]
    n_blocks = -(-nk // MOE_BLOCK) + MOE_EXPERTS
    n_rows = n_blocks * MOE_BLOCK
    row_tok = jnp.full((n_rows,), n, jnp.int32).at[dest].set(stok)
    row_w = jnp.zeros((n_rows,), jnp.float32).at[dest].set(sw)
    block_e = jnp.minimum(jnp.searchsorted(pad_ends, jnp.arange(n_blocks) * MOE_BLOCK, side='right'), MOE_EXPERTS - 1)
    xs = jnp.concatenate([t, jnp.zeros((1, d), t.dtype)], axis=0)[row_tok].reshape(n_blocks, MOE_BLOCK, d)

    def expert_block(args):
        xb, e = args
        hdn = jax.nn.silu(xb @ w1[e]) * (xb @ w3[e])
        return hdn @ w2[e]

    ys = lax.map(expert_block, (xs, block_e)).reshape(n_rows, d)
    out = jax.ops.segment_sum(ys * row_w[:, None].astype(ys.dtype), row_tok, num_segments=n + 1)
    return out[:n]


def setup_inputs(seed: int = 0) -> dict:
    key = jax.random.key(seed)
    ks = jax.random.split(key, 32)
    nrm = lambda k, shape, sc: jax.random.normal(k, shape, jnp.float32) * sc
    D = D_MODEL
    base_logit = jnp.log(2.0 ** (5.0 + jnp.arange(RET_HEADS, dtype=jnp.float32)) - 1.0)
    return {
        'x': nrm(ks[0], (BATCH, SEQ, D), 1.0),
        'c': nrm(ks[1], (BATCH, D), 1.0),
        'ctx': nrm(ks[2], (BATCH, CTX_LEN, D), 1.0),
        'c_ctx': nrm(ks[3], (D,), 1.0),
        'ada_w': nrm(ks[4], (DEPTH, D, 6 * D), 0.5 * D ** -0.5),
        'ada_b': nrm(ks[5], (DEPTH, 6 * D), 0.02),
        'ln_g': 1.0 + nrm(ks[6], (DEPTH, 2, D), 0.02),
        'ln_b': nrm(ks[7], (DEPTH, 2, D), 0.02),
        'ret_w_in': nrm(ks[8], (N_RET, D, 2 * RET_QK + 2 * RET_VW), D ** -0.5),
        'ret_decay': base_logit + nrm(ks[9], (N_RET, 2, RET_HEADS), 0.1),
        'ret_gn_g': 1.0 + nrm(ks[10], (N_RET, RET_VW), 0.02),
        'ret_w_out': nrm(ks[11], (N_RET, RET_VW, D), BETA * RET_VW ** -0.5),
        'mla_w_down': nrm(ks[12], (N_MLA, D, MLA_Q_LORA + MLA_KV_LORA + MLA_ROPE), D ** -0.5),
        'mla_q_norm': 1.0 + nrm(ks[13], (N_MLA, MLA_Q_LORA), 0.02),
        'mla_kv_norm': 1.0 + nrm(ks[14], (N_MLA, MLA_KV_LORA), 0.02),
        'mla_w_uq': nrm(ks[15], (N_MLA, MLA_Q_LORA, MLA_HEADS * (MLA_NOPE + MLA_ROPE)), MLA_Q_LORA ** -0.5),
        'mla_w_ukv': nrm(ks[16], (N_MLA, MLA_KV_LORA, MLA_HEADS * (MLA_NOPE + MLA_V)), MLA_KV_LORA ** -0.5),
        'mla_w_out': nrm(ks[17], (N_MLA, MLA_HEADS * MLA_V, D), BETA * (MLA_HEADS * MLA_V) ** -0.5),
        'conv_w_in': nrm(ks[18], (N_CONV, D, 3 * D), D ** -0.5),
        'conv_w': nrm(ks[19], (N_CONV, CONV_WIDTH, D), CONV_WIDTH ** -0.5),
        'conv_b': nrm(ks[20], (N_CONV, D), 0.02),
        'conv_w_out': nrm(ks[21], (N_CONV, D, D), BETA * D ** -0.5),
        'moe_w_group': nrm(ks[22], (DEPTH, D, MOE_GROUPS), D ** -0.5),
        'moe_b_group': nrm(ks[23], (DEPTH, MOE_GROUPS), 0.01),
        'moe_w_expert': nrm(ks[24], (DEPTH, D, MOE_EXPERTS), D ** -0.5),
        'moe_b_expert': nrm(ks[25], (DEPTH, MOE_EXPERTS), 0.01),
        'moe_w1': nrm(ks[26], (DEPTH, MOE_EXPERTS, D, MOE_HIDDEN), D ** -0.5),
        'moe_w3': nrm(ks[27], (DEPTH, MOE_EXPERTS, D, MOE_HIDDEN), D ** -0.5),
        'moe_w2': nrm(ks[28], (DEPTH, MOE_EXPERTS, MOE_HIDDEN, D), BETA * MOE_HIDDEN ** -0.5),
    }


def reference(x, c, ctx, c_ctx, ada_w, ada_b, ln_g, ln_b, ret_w_in, ret_decay, ret_gn_g, ret_w_out,
              mla_w_down, mla_q_norm, mla_kv_norm, mla_w_uq, mla_w_ukv, mla_w_out,
              conv_w_in, conv_w, conv_b, conv_w_out,
              moe_w_group, moe_b_group, moe_w_expert, moe_b_expert, moe_w1, moe_w3, moe_w2):
    b, s, d = x.shape
    n_ctx = ctx.shape[1]
    h_lat, h_ctx = x, ctx
    act_lat = jax.nn.silu(c)[:, None, :]
    act_ctx = jax.nn.silu(c_ctx)[None, None, :]
    for i in range(DEPTH):
        need_ctx = i < DEPTH - 1
        kind, j = i % N_MIXERS, i // N_MIXERS
        m_lat = jnp.split(act_lat @ ada_w[i] + ada_b[i], 6, axis=-1)
        m_ctx = jnp.split(act_ctx @ ada_w[i] + ada_b[i], 6, axis=-1)
        u_lat = modulate(h_lat, m_lat[0], m_lat[1])
        u_ctx = modulate(h_ctx, m_ctx[0], m_ctx[1])
        if kind == 0:
            y_ctx, y_lat = retention_mixer(u_ctx, u_lat, ret_w_in[j], ret_decay[j], ret_gn_g[j], ret_w_out[j], need_ctx)
        elif kind == 1:
            y_ctx, y_lat = mla_mixer(u_ctx, u_lat, mla_w_down[j], mla_q_norm[j], mla_kv_norm[j],
                                     mla_w_uq[j], mla_w_ukv[j], mla_w_out[j], need_ctx)
        else:
            y_lat = conv_mixer(u_lat, conv_w_in[j], conv_w[j], conv_b[j], conv_w_out[j])
            y_ctx = conv_mixer(u_ctx, conv_w_in[j], conv_w[j], conv_b[j], conv_w_out[j]) if need_ctx else None
        h_lat = layer_norm(ALPHA * h_lat + m_lat[2] * y_lat, ln_g[i, 0], ln_b[i, 0])
        v_lat = modulate(h_lat, m_lat[3], m_lat[4]).reshape(b * s, d)
        if need_ctx:
            h_ctx = layer_norm(ALPHA * h_ctx + m_ctx[2] * y_ctx, ln_g[i, 0], ln_b[i, 0])
            v_ctx = modulate(h_ctx, m_ctx[3], m_ctx[4]).reshape(b * n_ctx, d)
            tokens = jnp.concatenate([v_ctx, v_lat], axis=0)
        else:
            tokens = v_lat
        f = hier_moe(tokens, moe_w_group[i], moe_b_group[i], moe_w_expert[i], moe_b_expert[i],
                     moe_w1[i], moe_w3[i], moe_w2[i])
        f_lat = f[f.shape[0] - b * s:].reshape(b, s, d)
        h_lat = layer_norm(ALPHA * h_lat + m_lat[5] * f_lat, ln_g[i, 1], ln_b[i, 1])
        if need_ctx:
            f_ctx = f[:b * n_ctx].reshape(b, n_ctx, d)
            h_ctx = layer_norm(ALPHA * h_ctx + m_ctx[5] * f_ctx, ln_g[i, 1], ln_b[i, 1])
    return h_lat
```

```cpp
#include <hip/hip_runtime.h>
#include <cstdio>
#include <cstdint>

#define DI __device__ __forceinline__
#define LAS __attribute__((address_space(3)))
#define PG8_LAS LAS
typedef unsigned short bf16_t;
typedef short bf16x8 __attribute__((ext_vector_type(8)));
typedef short s16x4 __attribute__((ext_vector_type(4)));
typedef float f32x4 __attribute__((ext_vector_type(4)));
typedef float f32x2 __attribute__((ext_vector_type(2)));
typedef float f32x8 __attribute__((ext_vector_type(8)));
typedef float f32x16 __attribute__((ext_vector_type(16)));
typedef unsigned u32x4 __attribute__((ext_vector_type(4)));
typedef unsigned u32x2 __attribute__((ext_vector_type(2)));

constexpr int DM = 1024, NB = 16, SEQ = 4096, CTXL = 256, DEPTH = 4;
constexpr int NCTX = NB * CTXL, NLAT = NB * SEQ, NTOK = NCTX + NLAT;
constexpr float ALPHA = 1.6817928305074292f;
constexpr float LN_EPS = 1e-5f, RMS_EPS = 1e-6f;
constexpr int NEXP = 32, MOE_H = 512;
constexpr int NSLOT = 2 * NTOK;
constexpr int MAXROWS = 147456;
constexpr int KVLEN = CTXL + SEQ;
constexpr int LDS_BYTES = 163840;
constexpr int XB_LDS_OFF = LDS_BYTES - 16;
constexpr int NTHREADS = 512;

constexpr size_t al256(size_t x) { return (x + 255) / 256 * 256; }
constexpr size_t WS_CTL   = 0;
constexpr size_t CTL_BYTES = 32768;
constexpr size_t CTL_GCOUNT = 16384;
constexpr size_t WS_MOD   = WS_CTL + CTL_BYTES;
constexpr size_t WS_ROPE  = al256(WS_MOD + (size_t)4 * 17 * 6144 * 4);
constexpr size_t WS_HC    = al256(WS_ROPE + (size_t)(2 * 4096 + 2 * 1024) * 4);
constexpr size_t WS_U     = al256(WS_HC + (size_t)NCTX * DM * 4);
constexpr size_t WS_WMIX  = al256(WS_U + (size_t)NTOK * DM * 2);
constexpr size_t WMIX_ELEMS = (size_t)6144 * 1024 + (size_t)1024 * 2048;
constexpr size_t WS_W13   = al256(WS_WMIX + WMIX_ELEMS * 2);
constexpr size_t WS_W2    = al256(WS_W13 + (size_t)32 * 1024 * 1024 * 2);
constexpr size_t WS_SLOTE = al256(WS_W2 + (size_t)32 * 1024 * 512 * 2);
constexpr size_t WS_SLOTR = al256(WS_SLOTE + (size_t)NSLOT * 4);
constexpr size_t WS_SLOTW = al256(WS_SLOTR + (size_t)NSLOT * 4);
constexpr size_t WS_ROWTOK = al256(WS_SLOTW + (size_t)NSLOT * 4);
constexpr size_t WS_ROWW  = al256(WS_ROWTOK + (size_t)MAXROWS * 4);
constexpr size_t WS_STATS = al256(WS_ROWW + (size_t)MAXROWS * 4);
constexpr size_t WS_S     = al256(WS_STATS + (size_t)NTOK * 4 * 16 * 4);
constexpr size_t S_QKV = 0;
constexpr size_t S_O   = (size_t)NTOK * 4096 * 2;
constexpr size_t S_RET_END = S_O + (size_t)NTOK * 2048 * 2;
constexpr size_t S_DWN = 0;
constexpr size_t S_DQ  = al256(S_DWN + (size_t)NTOK * 768 * 2);
constexpr size_t S_DKV = al256(S_DQ + (size_t)NTOK * 384 * 2);
constexpr size_t S_AO  = 0;
constexpr size_t S_MQ  = al256(S_DKV + (size_t)NTOK * 256 * 2);
constexpr size_t S_KK  = al256(S_MQ + (size_t)NTOK * 1536 * 2);
constexpr size_t S_VV  = al256(S_KK + (size_t)NB * 8 * KVLEN * 192 * 2);
constexpr size_t S_MLA_END = S_VV + (size_t)NB * 8 * KVLEN * 128 * 2;
static_assert(S_MQ >= (size_t)NTOK * 1024 * 2, "AO alias fits");
constexpr size_t S_PB = 0, S_GB = (size_t)NTOK * 1024 * 2, S_A2 = 2 * S_GB, S_CONV_END = 3 * S_GB;
constexpr size_t S_XS  = 0;
constexpr size_t S_HDN = (size_t)MAXROWS * 1024 * 2;
constexpr size_t S_YS  = S_HDN + (size_t)MAXROWS * 512 * 2;
constexpr size_t S_MOE_END = S_YS + (size_t)NSLOT * 1024 * 2;
constexpr size_t cmax(size_t a, size_t b) { return a > b ? a : b; }
constexpr size_t S_BYTES = cmax(cmax(S_RET_END, S_MLA_END), cmax(S_CONV_END, S_MOE_END));
constexpr size_t WS_END = WS_S + S_BYTES;

struct Params { const float* in[29]; float* out; unsigned char* ws; };

DI float bf2f(unsigned short x) { return __uint_as_float(((unsigned)x) << 16); }
DI unsigned cvt_pk_bf16(float lo, float hi) { unsigned r; asm volatile("v_cvt_pk_bf16_f32 %0, %1, %2" : "=v"(r) : "v"(lo), "v"(hi)); return r; }
DI float bflo(unsigned w) { return __uint_as_float(w << 16); }
DI float bfhi(unsigned w) { return __uint_as_float(w & 0xffff0000u); }
DI float wave_sum(float v) {
#pragma unroll
    for (int m = 32; m >= 1; m >>= 1) v += __shfl_xor(v, m, 64);
    return v;
}
DI float silu_f(float a) { return a / (1.0f + __expf(-a)); }
DI u32x4 pack8(const f32x4& a, const f32x4& b) { u32x4 w; w.x = cvt_pk_bf16(a[0], a[1]); w.y = cvt_pk_bf16(a[2], a[3]); w.z = cvt_pk_bf16(b[0], b[1]); w.w = cvt_pk_bf16(b[2], b[3]); return w; }
static_assert(WS_END <= 1250000000ull, "workspace budget (guaranteed >= sum of inputs = 1.287 GB)");
#define XB_TMO      128
#define XB_XCNT(j)  (256  + 64 * (j))
#define XB_XSUB(j)  (1280 + 64 * (j))
#define XB_XGEN(j)  (2304 + 64 * (j))
#define XB_TOP      3328
#define XB_TOPGEN   3392
#define XCD_BAR_WORDS 3456
#define XB_SPIN_CAP (1u << 20)

__device__ __forceinline__ unsigned xb_ld(unsigned* p)              { return __hip_atomic_load((__attribute__((address_space(1))) unsigned*)p, __ATOMIC_RELAXED, __HIP_MEMORY_SCOPE_AGENT); }
__device__ __forceinline__ unsigned xb_add(unsigned* p, unsigned v) { return __hip_atomic_fetch_add((__attribute__((address_space(1))) unsigned*)p, v, __ATOMIC_RELAXED, __HIP_MEMORY_SCOPE_AGENT); }
__device__ __forceinline__ unsigned xb_xcc_id() { return (unsigned)__builtin_amdgcn_s_getreg((3 << 11) | 20) & 0xFu; }
#define XB_SPIN(cond, bar) do { unsigned _sp = 0; while (cond) { __builtin_amdgcn_s_sleep(1); \
    if ((++_sp & 255u) == 0u) { if (xb_ld(&(bar)[XB_TMO])) break; if (_sp > XB_SPIN_CAP) { atomicAdd(&(bar)[XB_TMO], 1u); break; } } } } while (0)

struct XcdBarrier {
    unsigned* bar; unsigned x;
    volatile LAS unsigned* st;
};

__device__ __forceinline__ XcdBarrier xcd_barrier_post(unsigned* bar, volatile LAS unsigned* st) {
    XcdBarrier b; b.bar = bar; b.x = xb_xcc_id(); b.st = st;
    if (threadIdx.x == 0) (void)xb_add(&bar[XB_XCNT(b.x)], 1u);
    return b;
}
__device__ __forceinline__ void xcd_barrier_complete(unsigned* bar, unsigned x, unsigned& nloc, unsigned& nx) {
    const unsigned G = gridDim.x * gridDim.y * gridDim.z;
    unsigned sum, cnt, mine, sp = 0u;
    for (;;) {
        sum = 0u; cnt = 0u; mine = 0u;
#pragma unroll
        for (unsigned j = 0; j < 16; ++j) { const unsigned c = xb_ld(&bar[XB_XCNT(j)]); sum += c; cnt += (c > 0u) ? 1u : 0u; mine = (j == x) ? c : mine; }
        if (sum == G) break;
        __builtin_amdgcn_s_sleep(1);
        if ((++sp & 255u) == 0u) { if (xb_ld(&bar[XB_TMO])) break; if (sp > XB_SPIN_CAP) { atomicAdd(&bar[XB_TMO], 1u); break; } }
    }
    nloc = mine > 0u ? mine : 1u; nx = cnt > 0u ? cnt : 1u;
}

__device__ __forceinline__ void xcd_barrier(const XcdBarrier& b) {
    asm volatile("s_waitcnt vmcnt(0)" ::: "memory");
    __syncthreads();
    if (threadIdx.x == 0) {
        unsigned* bar = b.bar;
        __builtin_amdgcn_s_waitcnt(0);
        unsigned nloc = b.st[0], nx = b.st[1];
        if (nloc == 0u) { xcd_barrier_complete(bar, b.x, nloc, nx); b.st[0] = nloc; b.st[1] = nx; }
        const unsigned old = xb_add(&bar[XB_XSUB(b.x)], 1u);
        const unsigned gen = old / nloc;
        if (old + 1u == (gen + 1u) * nloc) {
            __builtin_amdgcn_fence(__ATOMIC_RELEASE, "agent");
            asm volatile("s_waitcnt vmcnt(0)" ::: "memory");
            const unsigned og = xb_add(&bar[XB_TOP], 1u);
            const unsigned tg = og / nx;
            if (og + 1u == (tg + 1u) * nx) xb_add(&bar[XB_TOPGEN], 1u);
            else XB_SPIN(xb_ld(&bar[XB_TOPGEN]) == tg, bar);
            __builtin_amdgcn_fence(__ATOMIC_ACQUIRE, "agent");
            xb_add(&bar[XB_XGEN(b.x)], 1u);
            asm volatile("s_waitcnt vmcnt(0)" ::: "memory");
        } else {
            XB_SPIN(xb_ld(&bar[XB_XGEN(b.x)]) == gen, bar);
            __builtin_amdgcn_fence(__ATOMIC_ACQUIRE, "agent");
            asm volatile("s_waitcnt vmcnt(0)" ::: "memory");
        }
    }
    __syncthreads();
}
namespace pg8 {
constexpr int BM = 256, BK = 64, HALF = 128, HTB = HALF * BK * 2  , STAGE_BYTES = 8 * HTB, NXCD = 8, WGM = 8;

__host__ __device__ __forceinline__ int lds_byte(int r, int c) { const int st = (r >> 4) * 2 + (c >> 5), rr = r & 15, cc = c & 31, ob = rr * 64 + cc * 2; return st * 1024 + (ob ^ (((ob >> 9) & 1) << 5)); }
__host__ __device__ __forceinline__ void stage_rc(int b, int& R, int& C) { const int st = b / 1024, sb = b % 1024, swz = sb ^ (((sb >> 9) & 1) << 5); R = (st >> 1) * 16 + swz / 64; C = (st & 1) * 32 + (swz % 64) / 2; }
__host__ __device__ __forceinline__ int perm32(int rho) { const int n = rho >> 4, i = rho & 15; return 8 * (i >> 2) + 4 * n + (i & 3); }

struct Unit { int pm, pn; };
struct Gemm { const bf16_t* A; const bf16_t* Bt; int M, N, K; };

struct StaticOrder {
    int nM, nN, nwg, G, c;
    __host__ __device__ void init(int M, int N, int G_, int c_) { nM = M / BM; nN = N / BM; nwg = nM * nN; G = G_; c = c_; }
    __host__ __device__ bool next(int i, Unit& u) const {
        const long L = (long)i * G + c; if (L >= nwg) return false;
        int wgid = (int)L; { const int q = nwg / NXCD, r = nwg % NXCD, xcd = wgid % NXCD, off = wgid / NXCD; wgid = (xcd < r ? xcd * (q + 1) : r * (q + 1) + (xcd - r) * q) + off; }
        const int nig = WGM * nN, gid = wgid / nig, fm = gid * WGM, gsz = (nM - fm) < WGM ? (nM - fm) : WGM;
        u.pm = fm + ((wgid % nig) % gsz); u.pn = (wgid % nig) / gsz; return true;
    }
    __device__ __forceinline__ void a_ready(const Unit&) const {}
    __device__ __forceinline__ void done(const Unit&) const {}
};
struct GroupedOrder {
    int ntile, ncol, G, c; const LAS int* tile_e;
    __device__ __forceinline__ bool next(int i, Unit& u) const {
        const int L = i * G + c; if (L >= ntile * ncol) return false;
        const int t = L / ncol, pl = L - t * ncol; u.pm = t; u.pn = tile_e[t] * ncol + pl; return true;
    }
    __device__ __forceinline__ void a_ready(const Unit&) const {}
    __device__ __forceinline__ void done(const Unit&) const {}
};

#define EPI_ARGS const f32x4 (&acc)[2][2][4][2], const Unit& u, int wr, int wc, int fr, int fq

struct EpiBf16Plain { static constexpr bool PERM = true, AFTER_DRAIN = false;
    bf16_t* O; int ldc;
    DI void operator()(EPI_ARGS) const {
        const int row0 = u.pm * BM + wr * 64 + fr, col0 = u.pn * BM + wc * 32 + 8 * fq;
#pragma unroll
        for (int ai = 0; ai < 2; ++ai)
#pragma unroll
            for (int m = 0; m < 4; ++m) { bf16_t* rowp = O + (size_t)(row0 + ai * HALF + m * 16) * ldc + col0;
#pragma unroll
                for (int bj = 0; bj < 2; ++bj) *(u32x4*)(rowp + bj * HALF) = pack8(acc[ai][bj][m][0], acc[ai][bj][m][1]); }
    }
};

struct EpiRetQKV { static constexpr bool PERM = true, AFTER_DRAIN = false;
    bf16_t* QKV; const float* RC; const float* RS;
    DI void operator()(EPI_ARGS) const {
        const int row0 = u.pm * BM + wr * 64 + fr, cb = wc * 32 + 8 * fq;
        const bool isqk = u.pn < 8, lat = u.pm >= 16; const float ksc = (u.pn >= 4 && u.pn < 8) ? 0.0625f : 1.0f;
        const int f0 = (wc & 1) * 32 + 8 * fq;
#pragma unroll
        for (int ai = 0; ai < 2; ++ai)
#pragma unroll
            for (int m = 0; m < 4; ++m) {
                const int row = row0 + ai * HALF + m * 16; bf16_t* dst = QKV + (size_t)row * 4096 + u.pn * 256 + cb;
                f32x4 x1a = acc[ai][0][m][0], x1b = acc[ai][0][m][1], x2a = acc[ai][1][m][0], x2b = acc[ai][1][m][1];
                if (isqk && lat) {
                    const int t = (row - NCTX) & 4095; const int p = (wc < 2) ? (t >> 6) : (t & 63);
                    const f32x4 c0 = *(const f32x4*)(RC + p * 64 + f0), c1 = *(const f32x4*)(RC + p * 64 + f0 + 4);
                    const f32x4 s0 = *(const f32x4*)(RS + p * 64 + f0), s1 = *(const f32x4*)(RS + p * 64 + f0 + 4);
                    const f32x4 o1a = x1a * c0 - x2a * s0, o1b = x1b * c1 - x2b * s1, o2a = x1a * s0 + x2a * c0, o2b = x1b * s1 + x2b * c1;
                    x1a = o1a; x1b = o1b; x2a = o2a; x2b = o2b;
                }
                x1a *= ksc; x1b *= ksc; x2a *= ksc; x2b *= ksc;
                *(u32x4*)(dst) = pack8(x1a, x1b); *(u32x4*)(dst + HALF) = pack8(x2a, x2b);
            }
    }
};

struct EpiRetGate { static constexpr bool PERM = true, AFTER_DRAIN = false;
    bf16_t* O; const float* STATS; const float* gn;
    DI void operator()(EPI_ARGS) const {
        const int row0 = u.pm * BM + wr * 64 + fr, col0 = u.pn * BM + wc * 32 + 8 * fq, head = u.pn >> 1;
        f32x4 gv[2][2];
#pragma unroll
        for (int bj = 0; bj < 2; ++bj)
#pragma unroll
            for (int n = 0; n < 2; ++n) gv[bj][n] = *(const f32x4*)(gn + col0 + bj * HALF + 4 * n);
#pragma unroll
        for (int ai = 0; ai < 2; ++ai)
#pragma unroll
            for (int m = 0; m < 4; ++m) {
                const int row = row0 + ai * HALF + m * 16;
                const float* st = STATS + ((size_t)row * 4 + head) * 16;
                const f32x4 a0 = *(const f32x4*)(st), a1 = *(const f32x4*)(st + 4), a2 = *(const f32x4*)(st + 8), a3 = *(const f32x4*)(st + 12);
                const float s = (a0[0] + a0[2]) + (a1[0] + a1[2]) + (a2[0] + a2[2]) + (a3[0] + a3[2]);
                const float ss = (a0[1] + a0[3]) + (a1[1] + a1[3]) + (a2[1] + a2[3]) + (a3[1] + a3[3]);
                const float mean = s * (1.0f / 512.0f); float var = ss * (1.0f / 512.0f) - mean * mean; var = var > 0.f ? var : 0.f;
                const float rstd = __builtin_amdgcn_rsqf(var + LN_EPS);
                bf16_t* rowp = O + (size_t)row * 2048 + col0;
#pragma unroll
                for (int bj = 0; bj < 2; ++bj) {
                    const u32x4 ov = *(const u32x4*)(rowp + bj * HALF);
                    f32x4 o0, o1; o0[0] = bflo(ov.x); o0[1] = bfhi(ov.x); o0[2] = bflo(ov.y); o0[3] = bfhi(ov.y); o1[0] = bflo(ov.z); o1[1] = bfhi(ov.z); o1[2] = bflo(ov.w); o1[3] = bfhi(ov.w);
                    f32x4 r0, r1;
#pragma unroll
                    for (int j = 0; j < 4; ++j) { r0[j] = silu_f(acc[ai][bj][m][0][j]) * ((o0[j] - mean) * rstd * gv[bj][0][j]); r1[j] = silu_f(acc[ai][bj][m][1][j]) * ((o1[j] - mean) * rstd * gv[bj][1][j]); }
                    *(u32x4*)(rowp + bj * HALF) = pack8(r0, r1);
                }
            }
    }
};

struct EpiResid { static constexpr bool PERM = false, AFTER_DRAIN = false;
    const float* src_c; const float* src_l; float* dst_c; float* dst_l; const float* modl; int gchunk;
    DI void operator()(EPI_ARGS) const {
        const int row0 = u.pm * BM + wr * 64 + fr, col0 = u.pn * BM + wc * 32 + 4 * fq;
        const bool lat = u.pm >= 16; const int bp = lat ? ((u.pm - 16) >> 4) : 16;
        const float* gsrc = modl + (size_t)bp * 6144 + gchunk * 1024 + col0;
        f32x4 gv[2][2];
#pragma unroll
        for (int bj = 0; bj < 2; ++bj)
#pragma unroll
            for (int n = 0; n < 2; ++n) gv[bj][n] = *(const f32x4*)(gsrc + bj * HALF + n * 16);
#pragma unroll
        for (int ai = 0; ai < 2; ++ai)
#pragma unroll
            for (int m = 0; m < 4; ++m) {
                const int row = row0 + ai * HALF + m * 16; const int rr = lat ? row - NCTX : row;
                const float* hs = (lat ? src_l : src_c) + (size_t)rr * DM + col0; float* hd = (lat ? dst_l : dst_c) + (size_t)rr * DM + col0;
#pragma unroll
                for (int bj = 0; bj < 2; ++bj)
#pragma unroll
                    for (int n = 0; n < 2; ++n) { const f32x4 h = *(const f32x4*)(hs + bj * HALF + n * 16); *(f32x4*)(hd + bj * HALF + n * 16) = h * ALPHA + gv[bj][n] * acc[ai][bj][m][n]; }
            }
    }
};

struct EpiMlaKV { static constexpr bool PERM = true, AFTER_DRAIN = false;
    bf16_t* KK; bf16_t* VV;
    DI void operator()(EPI_ARGS) const {
        const int cb = wc * 32 + 8 * fq, h = u.pn; int b, pos0;
        if (u.pm >= 16) { const int t = u.pm - 16; b = t >> 4; pos0 = CTXL + (t & 15) * 256; } else { b = u.pm; pos0 = 0; }
        const size_t kv0 = (size_t)(b * 8 + h) * KVLEN + pos0 + wr * 64 + fr;
        bf16_t* kp = KK + kv0 * 192 + cb; bf16_t* vp = VV + kv0 * 128 + cb;
#pragma unroll
        for (int ai = 0; ai < 2; ++ai)
#pragma unroll
            for (int m = 0; m < 4; ++m) { const int ro = ai * HALF + m * 16;
                *(u32x4*)(kp + ro * 192) = pack8(acc[ai][0][m][0], acc[ai][0][m][1]);
                *(u32x4*)(vp + ro * 128) = pack8(acc[ai][1][m][0], acc[ai][1][m][1]); }
    }
};

struct EpiConvIn { static constexpr bool PERM = true, AFTER_DRAIN = false;
    bf16_t* GB; bf16_t* PB;
    DI void operator()(EPI_ARGS) const {
        const int row0 = u.pm * BM + wr * 64 + fr, cb = wc * 32 + 8 * fq;
#pragma unroll
        for (int ai = 0; ai < 2; ++ai)
#pragma unroll
            for (int m = 0; m < 4; ++m) {
                const int row = row0 + ai * HALF + m * 16;
                if (u.pn < 4) { bf16_t* rowp = GB + (size_t)row * DM + u.pn * 256 + cb;
                    *(u32x4*)(rowp) = pack8(acc[ai][0][m][0], acc[ai][0][m][1]); *(u32x4*)(rowp + HALF) = pack8(acc[ai][1][m][0], acc[ai][1][m][1]); }
                else { bf16_t* rowp = PB + (size_t)row * DM + (u.pn - 4) * 128 + cb;
                    *(u32x4*)(rowp) = pack8(acc[ai][0][m][0] * acc[ai][1][m][0], acc[ai][0][m][1] * acc[ai][1][m][1]); }
            }
    }
};

struct EpiMoe1 { static constexpr bool PERM = true, AFTER_DRAIN = false;
    bf16_t* HDN;
    DI void operator()(EPI_ARGS) const {
        const int row0 = u.pm * BM + wr * 64 + fr, cb = (u.pn & 3) * 128 + wc * 32 + 8 * fq;
#pragma unroll
        for (int ai = 0; ai < 2; ++ai)
#pragma unroll
            for (int m = 0; m < 4; ++m) {
                const int row = row0 + ai * HALF + m * 16; f32x4 r0, r1;
#pragma unroll
                for (int j = 0; j < 4; ++j) { r0[j] = silu_f(acc[ai][0][m][0][j]) * acc[ai][1][m][0][j]; r1[j] = silu_f(acc[ai][0][m][1][j]) * acc[ai][1][m][1][j]; }
                *(u32x4*)(HDN + (size_t)row * MOE_H + cb) = pack8(r0, r1);
            }
    }
};

struct EpiMoe2 { static constexpr bool PERM = true, AFTER_DRAIN = false;
    bf16_t* YS; const int* rowtok; const float* roww;
    DI void operator()(EPI_ARGS) const {
        const int row0 = u.pm * BM + wr * 64 + fr, cb = (u.pn & 3) * 256 + wc * 32 + 8 * fq;
#pragma unroll
        for (int ai = 0; ai < 2; ++ai)
#pragma unroll
            for (int m = 0; m < 4; ++m) {
                const int row = row0 + ai * HALF + m * 16; const int slot = rowtok[row];
                if (slot >= 0) { const float w = roww[row]; bf16_t* rowp = YS + (size_t)slot * DM + cb;
#pragma unroll
                    for (int bj = 0; bj < 2; ++bj) *(u32x4*)(rowp + bj * HALF) = pack8(acc[ai][bj][m][0] * w, acc[ai][bj][m][1] * w); }
            }
    }
};
template <class Epi, class Sched, bool STAMP = false>
__device__ __forceinline__ void gemm_phase(PG8_LAS unsigned char* lds, const Gemm g, const Sched& S, const Epi& E, unsigned long long* stamps, int wave_id) {
    int tid_l = (int)__builtin_amdgcn_mbcnt_hi(~0u, __builtin_amdgcn_mbcnt_lo(~0u, 0u)); asm volatile("" : "+v"(tid_l)); tid_l += 64 * wave_id;
    const int tid = tid_l, wid = __builtin_amdgcn_readfirstlane(tid >> 6), lane = tid & 63, wr = wid >> 2, wc = wid & 3, fr = lane & 15, fq = lane >> 4;
    const int K = g.K, nt = K / BK;
    int ts_lo = 0, ts_hi = 0, nts = 0; const unsigned long long rt_entry = STAMP ? (unsigned long long)wall_clock64() : 0ull;
#define PG8_STAMP() do { if (STAMP && wid == 0 && nts < 64) { const unsigned long long _c = (unsigned long long)clock64(); \
        ts_lo = (lane == nts) ? (int)(unsigned)_c : ts_lo; ts_hi = (lane == nts) ? (int)(unsigned)(_c >> 32) : ts_hi; ++nts; } } while (0)
    PG8_STAMP();
    unsigned voffA[2], voffB[2];
#pragma unroll
    for (int i = 0; i < 2; ++i) { int R, C; stage_rc(tid * 16 + i * 8192, R, C); const int Rb = Epi::PERM ? ((R & ~31) + perm32(R & 31)) : R;
        voffA[i] = (unsigned)(R * K + C) * 2u; voffB[i] = (unsigned)(Rb * K + C) * 2u; }
    const size_t kstep = (size_t)(BK * 2);
    const size_t hstep = (size_t)HALF * K * 2;
    const size_t tstep = 2 * hstep;
    const unsigned ldsw = (unsigned)wid * 1024u;
    const int aoff = lds_byte(wr * 64 + fr, fq * 8), boff = lds_byte(wc * 32 + fr, fq * 8);
#define PG8_SA(b, h) (((b) * 2 + (h)) * HTB)
#define PG8_SB(b, h) ((4 + (b) * 2 + (h)) * HTB)
#define PG8_STAGE(bufoff, gbase, voff) do { _Pragma("unroll") for (int _i = 0; _i < 2; ++_i) \
        __builtin_amdgcn_global_load_lds((const unsigned*)((const char*)(gbase) + (voff)[_i]), (PG8_LAS unsigned*)(lds + (bufoff) + ldsw + _i * 8192), 16, 0, 0); } while (0)
#define PG8_LDA(dst, b, h) do { _Pragma("unroll") for (int m = 0; m < 4; ++m) _Pragma("unroll") for (int k = 0; k < 2; ++k) dst[m][k] = *(const PG8_LAS bf16x8*)(lds + PG8_SA(b, h) + aoff + m * 2048 + k * 1024); } while (0)
#define PG8_LDB(dst, b, h) do { _Pragma("unroll") for (int n = 0; n < 2; ++n) _Pragma("unroll") for (int k = 0; k < 2; ++k) dst[n][k] = *(const PG8_LAS bf16x8*)(lds + PG8_SB(b, h) + boff + n * 2048 + k * 1024); } while (0)
#define PG8_MMA(ai, bj, At, Bt) do { __builtin_amdgcn_s_setprio(1); _Pragma("unroll") for (int m = 0; m < 4; ++m) _Pragma("unroll") for (int n = 0; n < 2; ++n) _Pragma("unroll") for (int k = 0; k < 2; ++k) \
        acc[ai][bj][m][n] = __builtin_amdgcn_mfma_f32_16x16x32_bf16(Bt[n][k], At[m][k], acc[ai][bj][m][n], 0, 0, 0); __builtin_amdgcn_s_setprio(0); } while (0)
#define PG8_WAIT_V(n) asm volatile("s_waitcnt vmcnt(" #n ")" ::: "memory")
#define PG8_WAIT_L(n) asm volatile("s_waitcnt lgkmcnt(" #n ")" ::: "memory")
#define PG8_BAR __builtin_amdgcn_s_barrier()
#define PG8_SCHED __builtin_amdgcn_sched_barrier(0)
    Unit cur, nxt; int ui = 0;
    if (!S.next(0, cur)) return;
    f32x4 acc[2][2][4][2];
#pragma unroll
    for (int a = 0; a < 2; ++a)
#pragma unroll
        for (int b = 0; b < 2; ++b)
#pragma unroll
            for (int m = 0; m < 4; ++m)
#pragma unroll
                for (int n = 0; n < 2; ++n) acc[a][b][m][n] = (f32x4){0.f, 0.f, 0.f, 0.f};
    bf16x8 At[4][2], B0[2][2], B1[2][2];
    const char* cA = (const char*)g.A + (size_t)cur.pm * tstep; const char* cB = (const char*)g.Bt + (size_t)cur.pn * tstep;
    S.a_ready(cur);
    PG8_STAGE(PG8_SB(0, 0), cB, voffB); PG8_STAGE(PG8_SA(0, 0), cA, voffA); PG8_STAGE(PG8_SB(0, 1), cB + hstep, voffB); PG8_STAGE(PG8_SA(0, 1), cA + hstep, voffA);
    if (wr == 1) PG8_BAR;
    PG8_WAIT_V(4); PG8_BAR;
    PG8_STAGE(PG8_SB(1, 0), cB + kstep, voffB); PG8_STAGE(PG8_SA(1, 0), cA + kstep, voffA); PG8_STAGE(PG8_SB(1, 1), cB + hstep + kstep, voffB);
    PG8_WAIT_V(6); PG8_BAR;
    PG8_STAMP();
    for (;;) {
        const bool has_next = S.next(ui + 1, nxt);
        const char* nA = has_next ? (const char*)g.A + (size_t)nxt.pm * tstep : cA; const char* nB = has_next ? (const char*)g.Bt + (size_t)nxt.pn * tstep : cB;
        for (int t = 0; t < nt; t += 2) {
            const bool last = (t == nt - 2);
            const char* a1 = cA + (size_t)(t + 1) * kstep;
            const char* a2 = last ? nA : cA + (size_t)(t + 2) * kstep; const char* b2 = last ? nB : cB + (size_t)(t + 2) * kstep;
            const char* a3 = a2 + kstep; const char* b3 = b2 + kstep;
            if (last && has_next) S.a_ready(nxt);
            PG8_LDB(B0, 0, 0); PG8_SCHED; PG8_LDA(At, 0, 0); PG8_STAGE(PG8_SA(1, 1), a1 + hstep, voffA);
            PG8_WAIT_L(8); PG8_BAR; PG8_WAIT_L(0); PG8_MMA(0, 0, At, B0); PG8_BAR; PG8_SCHED;
            PG8_LDB(B1, 0, 1); PG8_STAGE(PG8_SB(0, 0), b2, voffB);
            PG8_BAR; PG8_WAIT_L(0); PG8_MMA(0, 1, At, B1); PG8_BAR;
            PG8_LDA(At, 0, 1); PG8_STAGE(PG8_SA(0, 0), a2, voffA);
            PG8_BAR; PG8_WAIT_L(0); PG8_MMA(1, 0, At, B0); PG8_BAR; PG8_SCHED;
            PG8_STAGE(PG8_SB(0, 1), b2 + hstep, voffB);
            PG8_WAIT_V(6); PG8_BAR; PG8_MMA(1, 1, At, B1); PG8_BAR;
            PG8_LDB(B0, 1, 0); PG8_SCHED; PG8_LDA(At, 1, 0); PG8_STAGE(PG8_SA(0, 1), a2 + hstep, voffA);
            PG8_WAIT_L(8); PG8_BAR; PG8_WAIT_L(0); PG8_MMA(0, 0, At, B0); PG8_BAR; PG8_SCHED;
            PG8_LDB(B1, 1, 1); PG8_STAGE(PG8_SB(1, 0), b3, voffB);
            PG8_BAR; PG8_WAIT_L(0); PG8_MMA(0, 1, At, B1); PG8_BAR;
            PG8_LDA(At, 1, 1); PG8_STAGE(PG8_SA(1, 0), a3, voffA);
            PG8_BAR; PG8_WAIT_L(0); PG8_MMA(1, 0, At, B0); PG8_BAR; PG8_SCHED;
            PG8_STAGE(PG8_SB(1, 1), b3 + hstep, voffB);
            PG8_WAIT_V(6); PG8_BAR; PG8_MMA(1, 1, At, B1); PG8_BAR;
        }
        PG8_STAMP();
        if constexpr (!Epi::AFTER_DRAIN) { E(acc, cur, wr, wc, fr, fq); S.done(cur); }
        PG8_STAMP();
        if (!has_next) break;
#pragma unroll
        for (int a = 0; a < 2; ++a)
#pragma unroll
            for (int b = 0; b < 2; ++b)
#pragma unroll
                for (int m = 0; m < 4; ++m)
#pragma unroll
                    for (int n = 0; n < 2; ++n) acc[a][b][m][n] = (f32x4){0.f, 0.f, 0.f, 0.f};
        cur = nxt; cA = nA; cB = nB; ++ui;
    }
    PG8_WAIT_V(0);
    if (wr == 0) PG8_BAR;
    PG8_BAR;
    if constexpr (Epi::AFTER_DRAIN) { E.fused(acc, cur, wr, wc, fr, fq, lds, wid, lane); S.done(cur); }
    PG8_STAMP();
    if (STAMP && wid == 0) { stamps[lane] = lane < nts ? (((unsigned long long)(unsigned)ts_hi << 32) | (unsigned)ts_lo) : 0ull;
        if (lane == 62) stamps[62] = rt_entry; if (lane == 63) stamps[63] = (unsigned long long)wall_clock64(); }
#undef PG8_STAMP
#undef PG8_SA
#undef PG8_SB
#undef PG8_STAGE
#undef PG8_LDA
#undef PG8_LDB
#undef PG8_MMA
#undef PG8_WAIT_V
#undef PG8_WAIT_L
#undef PG8_BAR
#undef PG8_SCHED
}
}
struct Ctx {
    LAS unsigned char* lds; int tid, lane, wave, G, bid;
    unsigned char* ws;
    DI Ctx fresh() const { Ctx c = *this; int lid = (int)__builtin_amdgcn_mbcnt_hi(~0u, __builtin_amdgcn_mbcnt_lo(~0u, 0u)); int wv = wave, b = bid, g = G; asm volatile("" : "+v"(lid), "+s"(wv), "+s"(b), "+s"(g));
        c.tid = wv * 64 + lid; c.lane = lid; c.wave = wv; c.bid = b; c.G = g; return c; }
    DI const float* in(int i) const { return (const float*)(const __attribute__((address_space(1))) float*)P()->in[i]; }
    DI float* out() const { return (float*)(__attribute__((address_space(1))) float*)P()->out; }
    DI unsigned char* wsp() const { return (unsigned char*)(__attribute__((address_space(1))) unsigned char*)P()->ws; }
    DI const __attribute__((address_space(4))) Params* P() const { return (const __attribute__((address_space(4))) Params*)__builtin_amdgcn_kernarg_segment_ptr(); }
    DI float* MOD() const { return (float*)(ws + WS_MOD); }
    DI float* RC() const { return (float*)(ws + WS_ROPE); }
    DI float* RS() const { return RC() + 4096; }
    DI float* MC() const { return RC() + 8192; }
    DI float* MS() const { return RC() + 8192 + 1024; }
    DI float* HC() const { return (float*)(ws + WS_HC); }
    DI bf16_t* U() const { return (bf16_t*)(ws + WS_U); }
    DI bf16_t* WMIX() const { return (bf16_t*)(ws + WS_WMIX); }
    DI bf16_t* W13() const { return (bf16_t*)(ws + WS_W13); }
    DI bf16_t* W2() const { return (bf16_t*)(ws + WS_W2); }
    DI unsigned char* S() const { return ws + WS_S; }
};

DI void phase_mod(const Ctx& F) {
    LAS float* act = (LAS float*)F.lds;
    LAS float* red = act + 17 * 1024;
    const float* c = F.in(1); const float* cctx = F.in(3); const float* ada_w = F.in(4); const float* ada_b = F.in(5);
    for (int i = F.tid; i < 17 * 1024; i += NTHREADS) { const int b = i >> 10, k = i & 1023; const float x = b < 16 ? c[b * 1024 + k] : cctx[k]; act[i] = x / (1.0f + expf(-x)); }
    __syncthreads();
    for (int unit = F.bid; unit < 4 * 96; unit += F.G) {
        const int l = unit / 96, n0 = (unit % 96) * 64;
        const float* W = ada_w + (size_t)l * 1024 * 6144 + n0 + F.lane;
        float a[17];
#pragma unroll
        for (int b = 0; b < 17; ++b) a[b] = 0.f;
        const int k0 = F.wave * 128;
#pragma unroll 4
        for (int k = 0; k < 128; ++k) { const float w = W[(size_t)(k0 + k) * 6144];
#pragma unroll
            for (int b = 0; b < 17; ++b) a[b] += act[b * 1024 + k0 + k] * w; }
#pragma unroll
        for (int b = 0; b < 17; ++b) red[(F.wave * 17 + b) * 64 + F.lane] = a[b];
        __syncthreads();
        for (int i = F.tid; i < 17 * 64; i += NTHREADS) { const int b = i >> 6, n = i & 63; float s = ada_b[l * 6144 + n0 + n];
#pragma unroll
            for (int w = 0; w < 8; ++w) s += red[(w * 17 + b) * 64 + n];
            F.MOD()[((size_t)l * 17 + b) * 6144 + n0 + n] = s; }
        __syncthreads();
    }
}

DI void sincos_d(double a, double& s, double& c) {
    const double TWO_PI = 6.283185307179586476925286766559;
    const double n = rint(a / TWO_PI); const double r = a - n * TWO_PI;
    const double r2 = r * r; double ts = 1.0, tc = 1.0, ss = 1.0, cc = 1.0;
#pragma unroll
    for (int k = 1; k <= 16; ++k) { tc *= -r2 / (double)((2 * k - 1) * (2 * k)); cc += tc; ts *= -r2 / (double)((2 * k) * (2 * k + 1)); ss += ts; }
    s = r * ss; c = cc;
}
DI void phase_tables(const Ctx& F) {
    const int gt = F.bid * NTHREADS + F.tid, gs = F.G * NTHREADS;
    const double LN1E4 = 9.210340371976182736071965818737;
    for (int i = gt; i < 4096; i += gs) { const int p = i >> 6, f = i & 63; const double a = (double)p * exp(-LN1E4 * (double)f / 64.0); double s, c; sincos_d(a, s, c); F.RC()[i] = (float)c; F.RS()[i] = (float)s; }
    for (int i = gt; i < 1024; i += gs) { const int p = i >> 4, f = i & 15; const double a = (double)p * exp(-LN1E4 * (double)f / 16.0); double s, c; sincos_d(a, s, c); F.MC()[i] = (float)c; F.MS()[i] = (float)s; }
}

struct MapId   { const float* src; int ld; DI const float* col(int n0) const { return src + n0; } };
struct MapPad  { const float* src; int ld; int nvalid; DI const float* col(int n0) const { return n0 < nvalid ? src + n0 : nullptr; } };
struct MapConvIn { const float* src; int ld; DI const float* col(int n0) const { if (n0 < 1024) return src + n0; const int q = n0 - 1024, p = q >> 8, half = (q >> 7) & 1, i = q & 127; return src + 1024 + half * 1024 + p * 128 + i; } };
struct MapW13  { const float* w1; const float* w3; int ld; DI const float* col(int n0) const { const int e = n0 >> 10, nn = n0 & 1023, p = nn >> 8, half = (nn >> 7) & 1, i = nn & 127; return w1 + (ptrdiff_t)half * (w3 - w1) + (size_t)e * 1024 * 512 + p * 128 + i; } };
struct MapW2   { const float* w2; int ld; DI const float* col(int n0) const { const int e = n0 >> 10, nn = n0 & 1023; return w2 + (size_t)e * 512 * 1024 + nn; } };
template <class Map> DI void wconv_job(const Ctx& F, const Map& mp, int K, int Ndst, bf16_t* dst) {
    LAS float* tile = (LAS float*)F.lds;
    const int ntk = K / 64, nt = (Ndst / 64) * ntk;
    for (int t = F.bid; t < nt; t += F.G) {
        const int tn = t / ntk, tk = t - tn * ntk, n0 = tn * 64, k0 = tk * 64;
        const float* src = mp.col(n0);
#pragma unroll
        for (int it = 0; it < 8; ++it) { const int kk = it * 8 + (F.tid >> 6), nn = F.tid & 63; tile[kk * 65 + nn] = src ? src[(size_t)(k0 + kk) * mp.ld + nn] : 0.f; }
        __syncthreads();
#pragma unroll
        for (int it = 0; it < 4; ++it) { const int nn = it * 16 + (F.tid >> 5), kp = F.tid & 31;
            *(unsigned*)(dst + (size_t)(n0 + nn) * K + k0 + 2 * kp) = cvt_pk_bf16(tile[(2 * kp) * 65 + nn], tile[(2 * kp + 1) * 65 + nn]); }
        __syncthreads();
    }
}
constexpr size_t WM_RET_IN = 0, WM_RET_OUT = (size_t)6144 * 1024;
constexpr size_t WM_MLA_DOWN = 0, WM_MLA_UQ = (size_t)768 * 1024, WM_MLA_UKV = WM_MLA_UQ + (size_t)1536 * 384, WM_MLA_OUT = WM_MLA_UKV + (size_t)2048 * 256;
constexpr size_t WM_CONV_IN = 0, WM_CONV_OUT = (size_t)3072 * 1024;
DI void phase_wconv(const Ctx& F, int l) {
    const int kind = l % 3, j = l / 3;
    if (kind == 0) {
        wconv_job(F, MapId{F.in(8) + (size_t)j * 1024 * 6144, 6144}, 1024, 6144, F.WMIX() + WM_RET_IN);
        wconv_job(F, MapId{F.in(11) + (size_t)j * 2048 * 1024, 1024}, 2048, 1024, F.WMIX() + WM_RET_OUT);
    } else if (kind == 1) {
        wconv_job(F, MapPad{F.in(12), 704, 704}, 1024, 768, F.WMIX() + WM_MLA_DOWN);
        wconv_job(F, MapId{F.in(15), 1536}, 384, 1536, F.WMIX() + WM_MLA_UQ);
        wconv_job(F, MapId{F.in(16), 2048}, 256, 2048, F.WMIX() + WM_MLA_UKV);
        wconv_job(F, MapId{F.in(17), 1024}, 1024, 1024, F.WMIX() + WM_MLA_OUT);
    } else {
        wconv_job(F, MapConvIn{F.in(18), 3072}, 1024, 3072, F.WMIX() + WM_CONV_IN);
        wconv_job(F, MapId{F.in(21), 1024}, 1024, 1024, F.WMIX() + WM_CONV_OUT);
    }
    wconv_job(F, MapW13{F.in(26) + (size_t)l * 32 * 1024 * 512, F.in(27) + (size_t)l * 32 * 1024 * 512, 512}, 1024, 32 * 1024, F.W13());
    wconv_job(F, MapW2{F.in(28) + (size_t)l * 32 * 512 * 1024, 1024}, 512, 32 * 1024, F.W2());
}

DI const float* hrow_src(const Ctx& F, int l0, int row) { if (row < NCTX) return (l0 ? F.in(2) : F.HC()) + (size_t)row * DM; return (l0 ? F.in(0) : F.out()) + (size_t)(row - NCTX) * DM; }
DI float* hrow_dst(const Ctx& F, int row) { if (row < NCTX) return F.HC() + (size_t)row * DM; return F.out() + (size_t)(row - NCTX) * DM; }
DI int row_bp(int row) { return row < NCTX ? 16 : ((row - NCTX) >> 12); }

DI void phase_u0(const Ctx& F) {
    const float* mod0 = F.MOD();
    for (int row = F.bid * 4 + (F.tid >> 7); row < NTOK; row += F.G * 4) {
        const int c0 = (F.tid & 127) * 8; const float* h = hrow_src(F, 1, row) + c0; const float* m = mod0 + (size_t)row_bp(row) * 6144 + c0;
        const f32x4 h0 = *(const f32x4*)h, h1 = *(const f32x4*)(h + 4), sh0 = *(const f32x4*)m, sh1 = *(const f32x4*)(m + 4), sc0 = *(const f32x4*)(m + 1024), sc1 = *(const f32x4*)(m + 1028);
        *(u32x4*)(F.U() + (size_t)row * DM + c0) = pack8(h0 * (sc0 + 1.0f) + sh0, h1 * (sc1 + 1.0f) + sh1);
    }
}

constexpr int RT_WR = 0, RT_HIST = 147456, RT_BASE = RT_HIST + 128, RT_INFO = RT_BASE + 128;
constexpr int ROWS_PER_BLOCK = NTOK / 256;
static_assert(ROWS_PER_BLOCK * 256 == NTOK && ROWS_PER_BLOCK % 16 == 0, "row split");
DI void phase_ln1_router(const Ctx& F, int l) {
    LAS float* Wr = (LAS float*)(F.lds + RT_WR); LAS unsigned* hist = (LAS unsigned*)(F.lds + RT_HIST); LAS unsigned* base = (LAS unsigned*)(F.lds + RT_BASE); LAS unsigned* rinfo = (LAS unsigned*)(F.lds + RT_INFO);
    const float* wg = F.in(22) + (size_t)l * 1024 * 4; const float* bg = F.in(23) + l * 4; const float* we = F.in(24) + (size_t)l * 1024 * 32; const float* be = F.in(25) + l * 32;
    for (int i = F.tid; i < 36 * 1024; i += NTHREADS) { const int e = i >> 10, k = i & 1023; Wr[i] = e < 4 ? wg[k * 4 + e] : we[k * 32 + (e - 4)]; }
    if (F.tid < 32) hist[F.tid] = 0u;
    __syncthreads();
    const float* lng = F.in(6) + (size_t)(l * 2 + 0) * DM; const float* lnb = F.in(7) + (size_t)(l * 2 + 0) * DM;
    const float* modl = F.MOD() + (size_t)l * 17 * 6144;
    int* slot_e = (int*)(F.ws + WS_SLOTE); int* slot_r = (int*)(F.ws + WS_SLOTR); float* slot_w = (float*)(F.ws + WS_SLOTW);
    unsigned* gcount = (unsigned*)(F.ws + WS_CTL + CTL_GCOUNT) + l * 32;
    const int rblk = F.bid * ROWS_PER_BLOCK;
    f32x4 g4[4], b4[4];
#pragma unroll
    for (int j = 0; j < 4; ++j) { g4[j] = *(const f32x4*)(lng + F.lane * 4 + 256 * j); b4[j] = *(const f32x4*)(lnb + F.lane * 4 + 256 * j); }
    for (int it = 0; it < ROWS_PER_BLOCK / 8; ++it) {
        const int rl = F.wave * (ROWS_PER_BLOCK / 8) + it, row = rblk + rl;
        float* hp = hrow_dst(F, row) + F.lane * 4; const float* mp = modl + (size_t)row_bp(row) * 6144 + F.lane * 4;
        f32x4 z[4]; float s = 0.f;
#pragma unroll
        for (int j = 0; j < 4; ++j) { z[j] = *(const f32x4*)(hp + 256 * j); s += (z[j][0] + z[j][1]) + (z[j][2] + z[j][3]); }
        const float mean = wave_sum(s) * (1.0f / 1024.0f); float s2 = 0.f;
#pragma unroll
        for (int j = 0; j < 4; ++j) { z[j] -= mean; s2 += (z[j][0] * z[j][0] + z[j][1] * z[j][1]) + (z[j][2] * z[j][2] + z[j][3] * z[j][3]); }
        const float rstd = rsqrtf(wave_sum(s2) * (1.0f / 1024.0f) + LN_EPS);
        f32x4 v[4];
#pragma unroll
        for (int j = 0; j < 4; ++j) { const f32x4 h = z[j] * rstd * g4[j] + b4[j]; *(f32x4*)(hp + 256 * j) = h;
            const f32x4 sh = *(const f32x4*)(mp + 3 * 1024 + 256 * j), sc = *(const f32x4*)(mp + 4 * 1024 + 256 * j); v[j] = h * (sc + 1.0f) + sh;
            u32x2 w; w.x = cvt_pk_bf16(v[j][0], v[j][1]); w.y = cvt_pk_bf16(v[j][2], v[j][3]); *(u32x2*)(F.U() + (size_t)row * DM + F.lane * 4 + 256 * j) = w; }
        float lg[36];
#pragma unroll
        for (int e = 0; e < 36; ++e) { float a = 0.f;
#pragma unroll
            for (int j = 0; j < 4; ++j) { const f32x4 w = *(const LAS f32x4*)(Wr + e * 1024 + F.lane * 4 + 256 * j); a += (v[j][0] * w[0] + v[j][1] * w[1]) + (v[j][2] * w[2] + v[j][3] * w[3]); }
            lg[e] = wave_sum(a); }
        float gl[4];
#pragma unroll
        for (int g = 0; g < 4; ++g) gl[g] = lg[g] + bg[g];
        int gi = 0; float gm = gl[0];
#pragma unroll
        for (int g = 1; g < 4; ++g) if (gl[g] > gm) { gm = gl[g]; gi = g; }
        float gden = 0.f;
#pragma unroll
        for (int g = 0; g < 4; ++g) gden += expf(gl[g] - gm);
        const float gp = 1.0f / gden;
        float el[8];
#pragma unroll
        for (int q = 0; q < 8; ++q) { float x = lg[4 + q] + be[q];
#pragma unroll
            for (int g = 1; g < 4; ++g) x = (gi == g) ? (lg[4 + g * 8 + q] + be[g * 8 + q]) : x;
            el[q] = x; }
        int e0 = 0; float m0 = el[0];
#pragma unroll
        for (int q = 1; q < 8; ++q) if (el[q] > m0) { m0 = el[q]; e0 = q; }
        int e1 = -1; float m1 = -3.0e38f;
#pragma unroll
        for (int q = 0; q < 8; ++q) if (q != e0 && el[q] > m1) { m1 = el[q]; e1 = q; }
        const float t = expf(m1 - m0); const float w0 = gp / (1.0f + t), w1 = gp * t / (1.0f + t);
        if (F.lane == 0) {
            const int ex0 = gi * 8 + e0, ex1 = gi * 8 + e1;
            const unsigned r0 = atomicAdd((unsigned*)&hist[ex0], 1u); const unsigned r1 = atomicAdd((unsigned*)&hist[ex1], 1u);
            rinfo[rl * 2 + 0] = ((unsigned)ex0 << 24) | r0; rinfo[rl * 2 + 1] = ((unsigned)ex1 << 24) | r1;
            slot_w[(size_t)row * 2 + 0] = w0; slot_w[(size_t)row * 2 + 1] = w1;
        }
    }
    __syncthreads();
    if (F.tid < 32) base[F.tid] = atomicAdd(&gcount[F.tid], hist[F.tid]);
    __syncthreads();
    for (int i = F.tid; i < ROWS_PER_BLOCK * 2; i += NTHREADS) { const unsigned ri = rinfo[i]; const int e = (int)(ri >> 24); slot_e[(size_t)rblk * 2 + i] = e; slot_r[(size_t)rblk * 2 + i] = (int)(base[e] + (ri & 0xffffffu)); }
    __syncthreads();
}

DI void moe_prefix(const Ctx& F, int l, LAS int* ps  , LAS int* cnt  ) {
    const unsigned* gcount = (const unsigned*)(F.ws + WS_CTL + CTL_GCOUNT) + l * 32;
    if (F.tid < 32) cnt[F.tid] = (int)__hip_atomic_load(&gcount[F.tid], __ATOMIC_RELAXED, __HIP_MEMORY_SCOPE_AGENT);
    __syncthreads();
    if (F.tid == 0) { int a = 0; for (int e = 0; e < 32; ++e) { ps[e] = a; a += (cnt[e] + 255) / 256 * 256; } ps[32] = a; }
    __syncthreads();
}
DI void phase_moe_pos(const Ctx& F, int l) {
    LAS int* ps = (LAS int*)F.lds; LAS int* cnt = ps + 64;
    moe_prefix(F, l, ps, cnt);
    const int* slot_e = (const int*)(F.ws + WS_SLOTE); const int* slot_r = (const int*)(F.ws + WS_SLOTR); const float* slot_w = (const float*)(F.ws + WS_SLOTW);
    int* rowtok = (int*)(F.ws + WS_ROWTOK); float* roww = (float*)(F.ws + WS_ROWW);
    bf16_t* XS = (bf16_t*)(F.S() + S_XS);
    if (F.bid < 32) { const int e = F.bid; const int pe = (cnt[e] + 255) / 256 * 256; for (int i = cnt[e] + F.tid; i < pe; i += NTHREADS) rowtok[ps[e] + i] = -1; }
    for (int sl = (F.bid * 8 + F.wave); sl < NSLOT; sl += F.G * 8) {
        const int e = slot_e[sl]; const int dest = ps[e] + slot_r[sl];
        if (F.lane == 0) { rowtok[dest] = sl; roww[dest] = slot_w[sl]; }
        const bf16_t* src = F.U() + (size_t)(sl >> 1) * DM + F.lane * 8; bf16_t* dst = XS + (size_t)dest * DM + F.lane * 8;
        const u32x4 a = *(const u32x4*)src, b = *(const u32x4*)(src + 512); *(u32x4*)dst = a; *(u32x4*)(dst + 512) = b;
    }
}

DI void phase_ln2(const Ctx& F, int l) {
    const float* lng = F.in(6) + (size_t)(l * 2 + 1) * DM; const float* lnb = F.in(7) + (size_t)(l * 2 + 1) * DM;
    const float* modl = F.MOD() + (size_t)l * 17 * 6144; const float* modn = F.MOD() + (size_t)(l + 1) * 17 * 6144;
    const bf16_t* YS = (const bf16_t*)(F.S() + S_YS);
    f32x4 g4[4], b4[4];
#pragma unroll
    for (int j = 0; j < 4; ++j) { g4[j] = *(const f32x4*)(lng + F.lane * 4 + 256 * j); b4[j] = *(const f32x4*)(lnb + F.lane * 4 + 256 * j); }
    for (int row = F.bid * 8 + F.wave; row < NTOK; row += F.G * 8) {
        float* hp = hrow_dst(F, row) + F.lane * 4; const int bp = row_bp(row); const float* mp = modl + (size_t)bp * 6144 + 5 * 1024 + F.lane * 4;
        const bf16_t* y0 = YS + (size_t)row * 2 * DM + F.lane * 4; const bf16_t* y1 = y0 + DM;
        f32x4 z[4]; float s = 0.f;
#pragma unroll
        for (int j = 0; j < 4; ++j) { const f32x4 h = *(const f32x4*)(hp + 256 * j), gt = *(const f32x4*)(mp + 256 * j); const u32x2 a = *(const u32x2*)(y0 + 256 * j), b = *(const u32x2*)(y1 + 256 * j);
            f32x4 f; f[0] = bflo(a.x) + bflo(b.x); f[1] = bfhi(a.x) + bfhi(b.x); f[2] = bflo(a.y) + bflo(b.y); f[3] = bfhi(a.y) + bfhi(b.y);
            z[j] = h * ALPHA + gt * f; s += (z[j][0] + z[j][1]) + (z[j][2] + z[j][3]); }
        const float mean = wave_sum(s) * (1.0f / 1024.0f); float s2 = 0.f;
#pragma unroll
        for (int j = 0; j < 4; ++j) { z[j] -= mean; s2 += (z[j][0] * z[j][0] + z[j][1] * z[j][1]) + (z[j][2] * z[j][2] + z[j][3] * z[j][3]); }
        const float rstd = rsqrtf(wave_sum(s2) * (1.0f / 1024.0f) + LN_EPS);
#pragma unroll
        for (int j = 0; j < 4; ++j) { const f32x4 h = z[j] * rstd * g4[j] + b4[j]; *(f32x4*)(hp + 256 * j) = h;
            if (l + 1 < DEPTH) { const float* mn = modn + (size_t)bp * 6144 + F.lane * 4 + 256 * j; const f32x4 sh = *(const f32x4*)mn, sc = *(const f32x4*)(mn + 1024); const f32x4 v = h * (sc + 1.0f) + sh;
                u32x2 w; w.x = cvt_pk_bf16(v[0], v[1]); w.y = cvt_pk_bf16(v[2], v[3]); *(u32x2*)(F.U() + (size_t)row * DM + F.lane * 4 + 256 * j) = w; } }
    }
}

DI void phase_mla_prep(const Ctx& F) {
    const bf16_t* DWN = (const bf16_t*)(F.S() + S_DWN); bf16_t* DQ = (bf16_t*)(F.S() + S_DQ); bf16_t* DKV = (bf16_t*)(F.S() + S_DKV); bf16_t* KK = (bf16_t*)(F.S() + S_KK);
    const float* qn = F.in(13); const float* kn = F.in(14);
    for (int row = F.bid * 8 + F.wave; row < NTOK; row += F.G * 8) {
        const bf16_t* d = DWN + (size_t)row * 768;
        float q[6]; float sq = 0.f;
#pragma unroll
        for (int j = 0; j < 6; ++j) { q[j] = bf2f(d[F.lane + 64 * j]); sq += q[j] * q[j]; }
        const float rq = rsqrtf(wave_sum(sq) * (1.0f / 384.0f) + RMS_EPS);
#pragma unroll
        for (int j = 0; j < 6; ++j) { const float y = q[j] * rq * qn[F.lane + 64 * j]; DQ[(size_t)row * 384 + F.lane + 64 * j] = (bf16_t)(cvt_pk_bf16(y, 0.f) & 0xffffu); }
        float k[4]; float sk = 0.f;
#pragma unroll
        for (int j = 0; j < 4; ++j) { k[j] = bf2f(d[384 + F.lane + 64 * j]); sk += k[j] * k[j]; }
        const float rk = rsqrtf(wave_sum(sk) * (1.0f / 256.0f) + RMS_EPS);
#pragma unroll
        for (int j = 0; j < 4; ++j) { const float y = k[j] * rk * kn[F.lane + 64 * j]; DKV[(size_t)row * 256 + F.lane + 64 * j] = (bf16_t)(cvt_pk_bf16(y, 0.f) & 0xffffu); }
        float x = bf2f(d[640 + F.lane]); const float xo = __shfl_xor(x, 32, 64);
        int b, pos;
        if (row >= NCTX) { const int rr = row - NCTX; b = rr >> 12; const int t = rr & 4095; pos = CTXL + t;
            const int i = F.lane & 31; const int p = (i < 16) ? (t >> 6) : (t & 63); const float c = F.MC()[p * 16 + (i & 15)], s = F.MS()[p * 16 + (i & 15)];
            x = (F.lane < 32) ? (x * c - xo * s) : (xo * s + x * c);
        } else { b = row >> 8; pos = row & 255; }
        const bf16_t xb = (bf16_t)(cvt_pk_bf16(x, 0.f) & 0xffffu);
#pragma unroll
        for (int h = 0; h < 8; ++h) KK[((size_t)(b * 8 + h) * KVLEN + pos) * 192 + 128 + F.lane] = xb;
    }
}

DI void phase_conv(const Ctx& F) {
    const bf16_t* PB = (const bf16_t*)(F.S() + S_PB); const bf16_t* GB = (const bf16_t*)(F.S() + S_GB); bf16_t* A2 = (bf16_t*)(F.S() + S_A2);
    const float* cw = F.in(19); const float* cb = F.in(20);
    const int c0 = (F.tid & 127) * 8;
    f32x4 w0a = *(const f32x4*)(cw + c0), w0b = *(const f32x4*)(cw + c0 + 4), w1a = *(const f32x4*)(cw + 1024 + c0), w1b = *(const f32x4*)(cw + 1024 + c0 + 4), w2a = *(const f32x4*)(cw + 2048 + c0), w2b = *(const f32x4*)(cw + 2048 + c0 + 4);
    f32x4 ba = *(const f32x4*)(cb + c0), bb = *(const f32x4*)(cb + c0 + 4);
    for (int row = F.bid * 4 + (F.tid >> 7); row < NTOK; row += F.G * 4) {
        const int t = row < NCTX ? (row & 255) : ((row - NCTX) & 4095); const int tl = row < NCTX ? 255 : 4095;
        const u32x4 zero = {0u, 0u, 0u, 0u};
        const u32x4 pm = (t > 0) ? *(const u32x4*)(PB + (size_t)(row - 1) * DM + c0) : zero;
        const u32x4 pc = *(const u32x4*)(PB + (size_t)row * DM + c0);
        const u32x4 pp = (t < tl) ? *(const u32x4*)(PB + (size_t)(row + 1) * DM + c0) : zero;
        const u32x4 gb = *(const u32x4*)(GB + (size_t)row * DM + c0);
        f32x4 ra, rb;
#define CV(k, W) (bflo(pm.W) * w0##k + bflo(pc.W) * w1##k + bflo(pp.W) * w2##k)
        ra[0] = bflo(gb.x) * (bflo(pm.x) * w0a[0] + bflo(pc.x) * w1a[0] + bflo(pp.x) * w2a[0] + ba[0]);
        ra[1] = bfhi(gb.x) * (bfhi(pm.x) * w0a[1] + bfhi(pc.x) * w1a[1] + bfhi(pp.x) * w2a[1] + ba[1]);
        ra[2] = bflo(gb.y) * (bflo(pm.y) * w0a[2] + bflo(pc.y) * w1a[2] + bflo(pp.y) * w2a[2] + ba[2]);
        ra[3] = bfhi(gb.y) * (bfhi(pm.y) * w0a[3] + bfhi(pc.y) * w1a[3] + bfhi(pp.y) * w2a[3] + ba[3]);
        rb[0] = bflo(gb.z) * (bflo(pm.z) * w0b[0] + bflo(pc.z) * w1b[0] + bflo(pp.z) * w2b[0] + bb[0]);
        rb[1] = bfhi(gb.z) * (bfhi(pm.z) * w0b[1] + bfhi(pc.z) * w1b[1] + bfhi(pp.z) * w2b[1] + bb[1]);
        rb[2] = bflo(gb.w) * (bflo(pm.w) * w0b[2] + bflo(pc.w) * w1b[2] + bflo(pp.w) * w2b[2] + bb[2]);
        rb[3] = bfhi(gb.w) * (bfhi(pm.w) * w0b[3] + bfhi(pc.w) * w1b[3] + bfhi(pp.w) * w2b[3] + bb[3]);
#undef CV
        *(u32x4*)(A2 + (size_t)row * DM + c0) = pack8(ra, rb);
    }
}
constexpr int SC_Q = 0, SC_K = 32768, SC_V = 65536, SC_S = 81920, SC_P = 147456, SC_END = SC_P + 64 * 144;
static_assert(SC_END <= XB_LDS_OFF, "scan LDS");
DI unsigned off_a(unsigned row, unsigned ch) { return 2048u * (row >> 3) + 512u * (ch >> 2) + 64u * (row & 7) + 16u * ((ch & 3) ^ ((row >> 2) & 3)); }
#define MFMA16(a, b, c) __builtin_amdgcn_mfma_f32_16x16x32_bf16((a), (b), (c), 0, 0, 0)
DI void tr_read8(s16x4 (&r)[8], unsigned a0, unsigned a1, unsigned a2, unsigned a3, unsigned a4, unsigned a5, unsigned a6, unsigned a7) {
    asm volatile("ds_read_b64_tr_b16 %0, %8\n\tds_read_b64_tr_b16 %1, %9\n\tds_read_b64_tr_b16 %2, %10\n\tds_read_b64_tr_b16 %3, %11\n\t"
                 "ds_read_b64_tr_b16 %4, %12\n\tds_read_b64_tr_b16 %5, %13\n\tds_read_b64_tr_b16 %6, %14\n\tds_read_b64_tr_b16 %7, %15\n\ts_waitcnt lgkmcnt(0)"
                 : "=&v"(r[0]), "=&v"(r[1]), "=&v"(r[2]), "=&v"(r[3]), "=&v"(r[4]), "=&v"(r[5]), "=&v"(r[6]), "=&v"(r[7])
                 : "v"(a0), "v"(a1), "v"(a2), "v"(a3), "v"(a4), "v"(a5), "v"(a6), "v"(a7) : "memory");
}
DI void tr_read4(s16x4 (&r)[4], unsigned a0, unsigned a1, unsigned a2, unsigned a3) {
    asm volatile("ds_read_b64_tr_b16 %0, %4\n\tds_read_b64_tr_b16 %1, %5\n\tds_read_b64_tr_b16 %2, %6\n\tds_read_b64_tr_b16 %3, %7\n\ts_waitcnt lgkmcnt(0)"
                 : "=&v"(r[0]), "=&v"(r[1]), "=&v"(r[2]), "=&v"(r[3]) : "v"(a0), "v"(a1), "v"(a2), "v"(a3) : "memory");
}
DI bf16x8 cat4(const s16x4& lo, const s16x4& hi) { return __builtin_shufflevector(lo, hi, 0, 1, 2, 3, 4, 5, 6, 7); }
DI int scan_chunk_row(int b, int dir, int step) {
    if (dir == 0) return step < 4 ? b * 256 + step * 64 : NCTX + b * 4096 + (step - 4) * 64;
    return step < 4 ? b * 256 + (3 - step) * 64 : NCTX + b * 4096 + (67 - step) * 64;
}
DI void phase_ret_scan(const Ctx& F, int jl) {
    const bf16_t* QKV = (const bf16_t*)(F.S() + S_QKV); bf16_t* Obuf = (bf16_t*)(F.S() + S_O); float* STATS = (float*)(F.ws + WS_STATS);
    const float* decay = F.in(9) + jl * 8;
    LAS unsigned char* lds = F.lds; const unsigned ldsb = (unsigned)(uintptr_t)lds;
    const int w = F.wave, it = w >> 1, wh = w & 1;
    for (int item = F.bid; item < 256; item += F.G) {
        const int b = item >> 4, h = (item >> 2) & 3, sl = item & 3;
        for (int dir = 0; dir < 2; ++dir) {
            const float x = decay[dir * 4 + h]; const float lg2 = -log1pf(expf(-x)) * 1.4426950408889634f;
            const float gL = exp2f(lg2 * 64.0f);
            f32x4 st[2][8];
#pragma unroll
            for (int dd = 0; dd < 2; ++dd)
#pragma unroll
                for (int et = 0; et < 8; ++et) st[dd][et] = (f32x4){0.f, 0.f, 0.f, 0.f};
            u32x4 qreg[4], kreg[4], vreg[2];
            {   const int rb = scan_chunk_row(b, dir, 0);
                const int ch32 = F.tid & 31, qrow0 = F.tid >> 5, vch = F.tid & 15, vrow0 = F.tid >> 4;
#pragma unroll
                for (int i = 0; i < 4; ++i) { const bf16_t* src = QKV + (size_t)(rb + qrow0 + 16 * i) * 4096 + h * 256 + ch32 * 8; qreg[i] = *(const u32x4*)src; kreg[i] = *(const u32x4*)(src + 1024); }
#pragma unroll
                for (int i = 0; i < 2; ++i) vreg[i] = *(const u32x4*)(QKV + (size_t)(rb + vrow0 + 32 * i) * 4096 + 2048 + h * 512 + sl * 128 + vch * 8);
            }
            for (int step = 0; step < 68; ++step) {
                const int rb = scan_chunk_row(b, dir, step);
                int tz = F.tid; asm volatile("" : "+v"(tz));
                const int lane = tz & 63, g = lane >> 4, l15 = lane & 15, qd = l15 >> 2, pp = lane & 3, ph = pp >> 1;
                const int ch32 = tz & 31, qrow0 = tz >> 5, vch = tz & 15, vrow0 = tz >> 4;
                const unsigned rowbase = off_a(l15, g);
                unsigned trb[2][2];
#pragma unroll
                for (int t = 0; t < 2; ++t)
#pragma unroll
                    for (int par = 0; par < 2; ++par) trb[t][par] = ldsb + off_a(8 * g + 4 * t + qd, 2 * par + ph) + 8 * (pp & 1);
                const unsigned sdb0 = SC_S + 2048u * ((16 * 2 * w + l15) >> 3) + 64u * (l15 & 7) + 16u * ((g >> 1) ^ (qd & 1)) + 8u * (g & 1);
                const unsigned sdbp[2] = {sdb0 + 32u * (qd >> 1), sdb0 + 32u * (1 - (qd >> 1))};
#pragma unroll
                for (int dd = 0; dd < 2; ++dd)
#pragma unroll
                    for (int et = 0; et < 8; ++et) { st[dd][et] *= gL;
                        u32x2 pk; pk.x = cvt_pk_bf16(st[dd][et][0], st[dd][et][1]); pk.y = cvt_pk_bf16(st[dd][et][2], st[dd][et][3]);
                        *(LAS u32x2*)(lds + sdbp[et & 1] + 4096u * dd + 512u * (et >> 1)) = pk; }
#pragma unroll
                for (int i = 0; i < 4; ++i) { const unsigned o = (ch32 >> 4) * 16384 + off_a(qrow0, ch32 & 15) + 4096u * i; *(LAS u32x4*)(lds + SC_Q + o) = qreg[i]; *(LAS u32x4*)(lds + SC_K + o) = kreg[i]; }
#pragma unroll
                for (int i = 0; i < 2; ++i) { const int a = vrow0 + 32 * i; const float vs = exp2f(lg2 * (float)(dir == 0 ? 63 - a : a)); const u32x4 v = vreg[i]; u32x4 o;
                    o.x = cvt_pk_bf16(bflo(v.x) * vs, bfhi(v.x) * vs); o.y = cvt_pk_bf16(bflo(v.y) * vs, bfhi(v.y) * vs); o.z = cvt_pk_bf16(bflo(v.z) * vs, bfhi(v.z) * vs); o.w = cvt_pk_bf16(bflo(v.w) * vs, bfhi(v.w) * vs);
                    *(LAS u32x4*)(lds + SC_V + off_a(vrow0, vch) + 8192u * i) = o; }
                __syncthreads();
                if (step + 1 < 68) { const int rn = scan_chunk_row(b, dir, step + 1);
#pragma unroll
                    for (int i = 0; i < 4; ++i) { const bf16_t* src = QKV + (size_t)(rn + qrow0 + 16 * i) * 4096 + h * 256 + ch32 * 8; qreg[i] = *(const u32x4*)src; kreg[i] = *(const u32x4*)(src + 1024); }
#pragma unroll
                    for (int i = 0; i < 2; ++i) vreg[i] = *(const u32x4*)(QKV + (size_t)(rn + vrow0 + 32 * i) * 4096 + 2048 + h * 512 + sl * 128 + vch * 8);
                }
                f32x4 pacc[2]; pacc[0] = (f32x4){0.f, 0.f, 0.f, 0.f}; pacc[1] = pacc[0];
#pragma unroll
                for (int s8 = 0; s8 < 8; ++s8) { const unsigned io = (s8 >> 2) * 16384 + rowbase + 512 * (s8 & 3);
                    const bf16x8 qf = *(const LAS bf16x8*)(lds + SC_Q + io + 4096 * it);
#pragma unroll
                    for (int jj = 0; jj < 2; ++jj) { const bf16x8 kf = *(const LAS bf16x8*)(lds + SC_K + io + 4096 * (2 * wh + jj)); pacc[jj] = MFMA16(kf, qf, pacc[jj]); } }
#pragma unroll
                for (int jj = 0; jj < 2; ++jj) { const int i = 16 * it + l15, j0 = 16 * (2 * wh + jj) + 4 * g; f32x4 pv = pacc[jj];
#pragma unroll
                    for (int r = 0; r < 4; ++r) { const bool keep = (dir == 0) ? (j0 + r <= i) : (j0 + r >= i); pv[r] = keep ? pv[r] : 0.f; }
                    u32x2 pk; pk.x = cvt_pk_bf16(pv[0], pv[1]); pk.y = cvt_pk_bf16(pv[2], pv[3]); *(LAS u32x2*)(lds + SC_P + i * 144 + j0 * 2) = pk; }
                __syncthreads();
                f32x4 oacc[4];
#pragma unroll
                for (int e4 = 0; e4 < 4; ++e4) oacc[e4] = (f32x4){0.f, 0.f, 0.f, 0.f};
                const unsigned wo = 1024u * wh;
#pragma unroll
                for (int s8 = 0; s8 < 8; ++s8) { s16x4 r[8]; const unsigned o = SC_S + wo + 8192u * s8;
                    const bf16x8 qf = *(const LAS bf16x8*)(lds + SC_Q + (s8 >> 2) * 16384 + rowbase + 512 * (s8 & 3) + 4096 * it);
                    tr_read8(r, trb[0][0] + o, trb[1][0] + o, trb[0][1] + o, trb[1][1] + o, trb[0][0] + o + 512, trb[1][0] + o + 512, trb[0][1] + o + 512, trb[1][1] + o + 512);
                    __builtin_amdgcn_sched_barrier(0);
#pragma unroll
                    for (int e4 = 0; e4 < 4; ++e4) oacc[e4] = MFMA16(qf, cat4(r[2 * e4], r[2 * e4 + 1]), oacc[e4]); }
#pragma unroll
                for (int s = 0; s < 2; ++s) { s16x4 r[8]; const unsigned o = SC_V + wo + 8192u * s;
                    const bf16x8 pf = *(const LAS bf16x8*)(lds + SC_P + (16 * it + l15) * 144 + 16 * g + 64 * s);
                    tr_read8(r, trb[0][0] + o, trb[1][0] + o, trb[0][1] + o, trb[1][1] + o, trb[0][0] + o + 512, trb[1][0] + o + 512, trb[0][1] + o + 512, trb[1][1] + o + 512);
                    __builtin_amdgcn_sched_barrier(0);
#pragma unroll
                    for (int e4 = 0; e4 < 4; ++e4) oacc[e4] = MFMA16(pf, cat4(r[2 * e4], r[2 * e4 + 1]), oacc[e4]); }
                {   float ssum[4], ssq[4];
#pragma unroll
                    for (int r = 0; r < 4; ++r) { const int i = 16 * it + 4 * g + r; const float rs = exp2f(lg2 * (float)(dir == 0 ? i - 63 : -i));
                        bf16_t* op = Obuf + (size_t)(rb + i) * 2048 + h * 512 + sl * 128 + 64 * wh + l15; float s1 = 0.f, s2 = 0.f;
#pragma unroll
                        for (int e4 = 0; e4 < 4; ++e4) { float v = oacc[e4][r] * rs; if (dir == 1) v += bf2f(op[16 * e4]);
                            const unsigned pk = cvt_pk_bf16(v, 0.f); op[16 * e4] = (bf16_t)(pk & 0xffffu); const float vr = bflo(pk); s1 += vr; s2 += vr * vr; }
                        ssum[r] = s1; ssq[r] = s2; }
                    if (dir == 1) {
#pragma unroll
                        for (int r = 0; r < 4; ++r) {
#pragma unroll
                            for (int m = 1; m < 16; m <<= 1) { ssum[r] += __shfl_xor(ssum[r], m, 64); ssq[r] += __shfl_xor(ssq[r], m, 64); }
                            if (l15 == 0) { float* sp = STATS + ((size_t)(rb + 16 * it + 4 * g + r) * 4 + h) * 16 + (sl * 2 + wh) * 2; sp[0] = ssum[r]; sp[1] = ssq[r]; } }
                    }
                }
#pragma unroll
                for (int ks = 0; ks < 2; ++ks) {
                    s16x4 kr[4]; const unsigned ko = SC_K + (w >> 2) * 16384 + 512u * (w & 3) + 8192u * ks;
                    tr_read4(kr, trb[0][0] + ko, trb[1][0] + ko, trb[0][1] + ko, trb[1][1] + ko);
                    const bf16x8 kf0 = cat4(kr[0], kr[1]), kf1 = cat4(kr[2], kr[3]);
#pragma unroll
                    for (int eb = 0; eb < 2; ++eb) { s16x4 r[8]; const unsigned o = SC_V + 8192u * ks + 1024u * eb;
                        tr_read8(r, trb[0][0] + o, trb[1][0] + o, trb[0][1] + o, trb[1][1] + o, trb[0][0] + o + 512, trb[1][0] + o + 512, trb[0][1] + o + 512, trb[1][1] + o + 512);
                        __builtin_amdgcn_sched_barrier(0);
#pragma unroll
                        for (int e4 = 0; e4 < 4; ++e4) { const bf16x8 vf = cat4(r[2 * e4], r[2 * e4 + 1]);
                            st[0][4 * eb + e4] = MFMA16(vf, kf0, st[0][4 * eb + e4]); st[1][4 * eb + e4] = MFMA16(vf, kf1, st[1][4 * eb + e4]); } }
                }
                __syncthreads();
            }
        }
    }
}
namespace att {
constexpr int DQK = 192, DV = 128, NW = 8, QBLK = 32, KVBLK = 64;
constexpr float SCALE = 0.07216878364870322f;
constexpr float THR = 8.f;
constexpr int LDQ = 1536, LDK = 192, LDV = 128, LDO = 1024;
constexpr int SHM_V = KVBLK * DV * 2, SHM_K = KVBLK * DQK * 2, SHM_ATTN = 2 * SHM_V + 2 * SHM_K + NW * 64 * 4;
#define KSWZ(row, colB) ((row) * 384 + ((colB) ^ (((row) & 7) << 4)))
#define SBAR() __builtin_amdgcn_sched_barrier(0)
DI int crow(int r, int hi) { return (r & 3) + 8 * (r >> 2) + 4 * hi; }
DI unsigned cvtpk(float lo, float hi) { unsigned r; asm volatile("v_cvt_pk_bf16_f32 %0, %1, %2" : "=v"(r) : "v"(lo), "v"(hi)); return r; }
DI void partialSM(f32x16& p0, f32x16& p1, float& m_reg, float& mn, float& alpha) {
  constexpr float C = SCALE * 1.4426950408889634f;
  float pmax = p0[0];
#pragma unroll
  for (int r = 1; r < 16; ++r) pmax = fmaxf(pmax, p0[r]);
#pragma unroll
  for (int r = 0; r < 16; ++r) pmax = fmaxf(pmax, p1[r]);
  { auto rr = __builtin_amdgcn_permlane32_swap(__float_as_uint(pmax), __float_as_uint(pmax), false, false);
    pmax = fmaxf(__uint_as_float(rr[0]), __uint_as_float(rr[1])); }
  if (__builtin_expect(__all(pmax - m_reg <= THR / SCALE), 1)) { mn = m_reg; alpha = 1.f; }
  else { mn = fmaxf(m_reg, pmax); alpha = __builtin_amdgcn_exp2f((m_reg - mn) * C); m_reg = mn; }
  float mnC = -mn * C;
#pragma unroll
  for (int r = 0; r < 16; ++r) p0[r] = fmaf(p0[r], C, mnC);
#pragma unroll
  for (int r = 0; r < 16; ++r) p1[r] = fmaf(p1[r], C, mnC);
#pragma unroll
  for (int r = 0; r < 16; ++r) p0[r] = __builtin_amdgcn_exp2f(p0[r]);
}
DI void finishSM(f32x16& p0, f32x16& p1, float alpha, float& l_reg, bf16x8& pa0, bf16x8& pa1, bf16x8& pa2, bf16x8& pa3) {
#pragma unroll
  for (int r = 0; r < 16; ++r) p1[r] = __builtin_amdgcn_exp2f(p1[r]);
  float ps = 0;
#pragma unroll
  for (int r = 0; r < 16; ++r) ps += p0[r];
#pragma unroll
  for (int r = 0; r < 16; ++r) ps += p1[r];
  { auto rr = __builtin_amdgcn_permlane32_swap(__float_as_uint(ps), __float_as_uint(ps), false, false);
    ps = __uint_as_float(rr[0]) + __uint_as_float(rr[1]); }
  l_reg = l_reg * alpha + ps;
#define PK4(P, BASE, OUT) do { unsigned a0 = cvtpk(P[BASE + 0], P[BASE + 1]), a1 = cvtpk(P[BASE + 2], P[BASE + 3]);   \
    unsigned b0 = cvtpk(P[BASE + 4], P[BASE + 5]), b1 = cvtpk(P[BASE + 6], P[BASE + 7]);                              \
    auto r0 = __builtin_amdgcn_permlane32_swap(a0, b0, false, false); auto r1 = __builtin_amdgcn_permlane32_swap(a1, b1, false, false); \
    u32x4 w = {r0[0], r1[0], r0[1], r1[1]}; OUT = *reinterpret_cast<bf16x8*>(&w); } while (0)
  PK4(p0, 0, pa0); PK4(p0, 8, pa1); PK4(p1, 0, pa2); PK4(p1, 8, pa3);
#undef PK4
}
DI void qkt(f32x16& p0, f32x16& p1, const LAS char* Ks, const bf16x8 (&qr)[12], int r32, int hi) {
  p0 = f32x16{}; p1 = f32x16{};
#pragma unroll
  for (int d0 = 0; d0 < 12; ++d0) { const int cb = (d0 * 16 + hi * 8) * 2;
    const bf16x8 b0 = *reinterpret_cast<const LAS bf16x8*>(Ks + KSWZ(r32, cb));
    const bf16x8 b1 = *reinterpret_cast<const LAS bf16x8*>(Ks + KSWZ(32 + r32, cb));
    p0 = __builtin_amdgcn_mfma_f32_32x32x16_bf16(b0, qr[d0], p0, 0, 0, 0);
    p1 = __builtin_amdgcn_mfma_f32_32x32x16_bf16(b1, qr[d0], p1, 0, 0, 0); }
}
DI int v_st(int k, int c) { const int kk = (k & ~0xC) | ((k & 4) << 1) | ((k & 8) >> 1); return ((kk >> 3) * 4 + (c >> 5)) * 512 + ((kk & 7) * 32 + (c & 31)) * 2; }
DI int v_rd_base(int lane) { return ((lane & 3) << 3) | (((lane >> 2) & 3) << 6) | (((lane >> 4) & 1) << 5) | (((lane >> 5) & 1) << 8); }
constexpr int v_rd_off(int d0, int ks, int half) { return d0 * 512 + ks * 4096 + half * 2048; }
template <int OFF> DI s16x4 tr_read(int vb) { s16x4 r; asm volatile("ds_read_b64_tr_b16 %0, %1 offset:%2" : "=&v"(r) : "v"(vb), "i"(OFF) : "memory"); return r; }
template <int D0> DI void pv_one(f32x16& od, int vb, bf16x8 pa0, bf16x8 pa1, bf16x8 pa2, bf16x8 pa3) {
  const s16x4 l0 = tr_read<v_rd_off(D0, 0, 0)>(vb), h0 = tr_read<v_rd_off(D0, 0, 1)>(vb), l1 = tr_read<v_rd_off(D0, 1, 0)>(vb), h1 = tr_read<v_rd_off(D0, 1, 1)>(vb);
  const s16x4 l2 = tr_read<v_rd_off(D0, 2, 0)>(vb), h2 = tr_read<v_rd_off(D0, 2, 1)>(vb), l3 = tr_read<v_rd_off(D0, 3, 0)>(vb), h3 = tr_read<v_rd_off(D0, 3, 1)>(vb);
  asm volatile("s_waitcnt lgkmcnt(0)" ::: "memory"); SBAR();
#define PK(L, H) (bf16x8){L[0], L[1], L[2], L[3], H[0], H[1], H[2], H[3]}
  od = __builtin_amdgcn_mfma_f32_32x32x16_bf16(pa0, PK(l0, h0), od, 0, 0, 0);
  od = __builtin_amdgcn_mfma_f32_32x32x16_bf16(pa1, PK(l1, h1), od, 0, 0, 0);
  od = __builtin_amdgcn_mfma_f32_32x32x16_bf16(pa2, PK(l2, h2), od, 0, 0, 0);
  od = __builtin_amdgcn_mfma_f32_32x32x16_bf16(pa3, PK(l3, h3), od, 0, 0, 0);
#undef PK
}
DI void pv_d0(f32x16 (&o)[4], int vb, bf16x8 pa0, bf16x8 pa1, bf16x8 pa2, bf16x8 pa3) {
  pv_one<0>(o[0], vb, pa0, pa1, pa2, pa3); pv_one<1>(o[1], vb, pa0, pa1, pa2, pa3); pv_one<2>(o[2], vb, pa0, pa1, pa2, pa3); pv_one<3>(o[3], vb, pa0, pa1, pa2, pa3);
}
DI void rope8(bf16x8& a, bf16x8& b, const f32x4& c0, const f32x4& c1, const f32x4& s0, const f32x4& s1) {
  float x1[8], x2[8];
#pragma unroll
  for (int e = 0; e < 8; ++e) { x1[e] = bf2f((unsigned short)a[e]); x2[e] = bf2f((unsigned short)b[e]); }
  float o1[8], o2[8];
#pragma unroll
  for (int e = 0; e < 8; ++e) { const float c = e < 4 ? c0[e & 3] : c1[e & 3], s = e < 4 ? s0[e & 3] : s1[e & 3]; o1[e] = x1[e] * c - x2[e] * s; o2[e] = x1[e] * s + x2[e] * c; }
  u32x4 wa = {cvtpk(o1[0], o1[1]), cvtpk(o1[2], o1[3]), cvtpk(o1[4], o1[5]), cvtpk(o1[6], o1[7])}, wb = {cvtpk(o2[0], o2[1]), cvtpk(o2[2], o2[3]), cvtpk(o2[4], o2[5]), cvtpk(o2[6], o2[7])};
  a = *reinterpret_cast<bf16x8*>(&wa); b = *reinterpret_cast<bf16x8*>(&wb);
}
DI void attn_body(const bf16_t* __restrict__ Qb, const bf16_t* __restrict__ Kh, const bf16_t* __restrict__ Vh, bf16_t* __restrict__ Ob, int seq, int t0,
                  const float* __restrict__ MC, const float* __restrict__ MS, LAS char* lds, int wave_id) {
  int tid_l = (int)__builtin_amdgcn_mbcnt_hi(~0u, __builtin_amdgcn_mbcnt_lo(~0u, 0u)); asm volatile("" : "+v"(tid_l)); tid_l += 64 * wave_id;
  const int tid = tid_l, wid = tid >> 6, lane = tid & 63, r32 = lane & 31, hi = lane >> 5;
  LAS char* V_lds = lds; LAS char* K_lds = lds + 2 * SHM_V;
  LAS float* ws = (LAS float*)(lds + 2 * SHM_V + 2 * SHM_K) + wid * 64; LAS float* li_l = ws; LAS float* al_l = ws + 32;
  float m_reg = -1e30f, l_reg = 0; f32x16 o[4] = {}; bf16x8 qr[12];
  const bf16_t* Qw = Qb + (long)(wid * QBLK + r32) * LDQ + hi * 8;
#pragma unroll
  for (int d0 = 0; d0 < 12; ++d0) qr[d0] = *reinterpret_cast<const bf16x8*>(Qw + d0 * 16);
  if (t0 >= 0) { const int t = t0 + wid * QBLK + r32; const int pr = t >> 6, pc = t & 63;
    const f32x4 cr0 = *(const f32x4*)(MC + pr * 16 + hi * 8), cr1 = *(const f32x4*)(MC + pr * 16 + hi * 8 + 4), sr0 = *(const f32x4*)(MS + pr * 16 + hi * 8), sr1 = *(const f32x4*)(MS + pr * 16 + hi * 8 + 4);
    const f32x4 cc0 = *(const f32x4*)(MC + pc * 16 + hi * 8), cc1 = *(const f32x4*)(MC + pc * 16 + hi * 8 + 4), sc0 = *(const f32x4*)(MS + pc * 16 + hi * 8), sc1 = *(const f32x4*)(MS + pc * 16 + hi * 8 + 4);
    rope8(qr[8], qr[10], cr0, cr1, sr0, sr1); rope8(qr[9], qr[11], cc0, cc1, sc0, sc1); }
  const int sr = tid >> 4, sc = (tid & 15) * 8, vst0 = v_st(sr, sc), vst1 = v_st(32 + sr, sc);
  int krow[3], kcb[3];
#pragma unroll
  for (int i = 0; i < 3; ++i) { const int id = tid + 512 * i; krow[i] = id / 24; kcb[i] = (id - krow[i] * 24) * 16; }
  const int vb0 = (int)(uintptr_t)V_lds + v_rd_base(lane);
  u32x4 vs0, vs1, ks0, ks1, ks2;
#define SLOAD(k0) do { vs0 = *(const u32x4*)(Vh + (long)((k0) + sr) * LDV + sc); vs1 = *(const u32x4*)(Vh + (long)((k0) + 32 + sr) * LDV + sc); \
    ks0 = *(const u32x4*)((const char*)(Kh + (long)((k0) + krow[0]) * LDK) + kcb[0]); ks1 = *(const u32x4*)((const char*)(Kh + (long)((k0) + krow[1]) * LDK) + kcb[1]); \
    ks2 = *(const u32x4*)((const char*)(Kh + (long)((k0) + krow[2]) * LDK) + kcb[2]); } while (0)
#define SWRITE(b) do { *(LAS u32x4*)(V_lds + (b) * SHM_V + vst0) = vs0; *(LAS u32x4*)(V_lds + (b) * SHM_V + vst1) = vs1; \
    *(LAS u32x4*)(K_lds + (b) * SHM_K + KSWZ(krow[0], kcb[0])) = ks0; *(LAS u32x4*)(K_lds + (b) * SHM_K + KSWZ(krow[1], kcb[1])) = ks1; \
    *(LAS u32x4*)(K_lds + (b) * SHM_K + KSWZ(krow[2], kcb[2])) = ks2; } while (0)
#define SWAIT() asm volatile("s_waitcnt vmcnt(0)" ::: "memory")
#define RESC(a) do { if (__any((a) < 1.f)) { if (hi == 0) al_l[r32] = (a); asm volatile("s_waitcnt lgkmcnt(0)" ::: "memory"); \
    _Pragma("unroll") for (int d = 0; d < 4; ++d) _Pragma("unroll") for (int r = 0; r < 16; ++r) o[d][r] *= al_l[crow(r, hi)]; } } while (0)
  f32x16 p0, p1; float mn, al; bf16x8 pa0, pa1, pa2, pa3; const int NT = seq / KVBLK;
  SLOAD(0); SWAIT(); SWRITE(0); SLOAD(KVBLK); SWAIT(); SWRITE(1); __syncthreads();
#pragma unroll 1
  for (int j = 0; j < NT; ++j) {
    const int buf = j & 1;
    if (j + 2 < NT) SLOAD((j + 2) * KVBLK);
    SBAR(); qkt(p0, p1, K_lds + buf * SHM_K, qr, r32, hi);
    partialSM(p0, p1, m_reg, mn, al);
    RESC(al);
    finishSM(p0, p1, al, l_reg, pa0, pa1, pa2, pa3); SBAR();
    pv_d0(o, vb0 + buf * SHM_V, pa0, pa1, pa2, pa3);
    __syncthreads();
    if (j + 2 < NT) { SWAIT(); SWRITE(buf); }
  }
  if (hi == 0) li_l[r32] = l_reg; asm volatile("s_waitcnt lgkmcnt(0)" ::: "memory");
  float rli[16];
#pragma unroll
  for (int r = 0; r < 16; ++r) rli[r] = __builtin_amdgcn_rcpf(li_l[crow(r, hi)]);
  bf16_t* Ow = Ob + (long)(wid * QBLK) * LDO;
#pragma unroll
  for (int r = 0; r < 16; ++r) { const int orow = crow(r, hi);
#pragma unroll
    for (int d0 = 0; d0 < 4; ++d0) Ow[(long)orow * LDO + d0 * 32 + r32] = (bf16_t)(cvtpk(o[d0][r] * rli[r], 0.f) & 0xffffu); }
#undef SLOAD
#undef SWRITE
#undef SWAIT
#undef RESC
}
}

DI void phase_mla_attn(const Ctx& F) {
    const bf16_t* MQ = (const bf16_t*)(F.S() + S_MQ); const bf16_t* KK = (const bf16_t*)(F.S() + S_KK); const bf16_t* VV = (const bf16_t*)(F.S() + S_VV); bf16_t* AO = (bf16_t*)(F.S() + S_AO);
    const int c = F.bid, xcd = c & 7, jx = c >> 3;
    const int nlat = NB * 8 * 16, nctx = NB * 8;
#pragma unroll 1
    for (int i = 0; ; ++i) {
        int u = i * F.G + c;
        if (u >= nlat + nctx) break;
        int bh, seq, t0; size_t qrow;
        if (u < nlat) {
            if (F.G == 256) u = (((i * 2 + (jx >> 4)) * 8 + xcd) << 4) | (jx & 15);
            bh = u >> 4; const int qb = u & 15; qrow = (size_t)NCTX + (size_t)(bh >> 3) * 4096 + qb * 256; seq = KVLEN; t0 = qb * 256;
        } else { bh = u - nlat; qrow = (size_t)(bh >> 3) * 256; seq = CTXL; t0 = -1; }
        const int h = bh & 7;
        __syncthreads();
        att::attn_body(MQ + qrow * 1536 + h * 192, KK + (size_t)bh * KVLEN * 192, VV + (size_t)bh * KVLEN * 128, AO + qrow * 1024 + h * 128, seq, t0, F.MC(), F.MS(), (LAS char*)F.lds, F.wave);
    }
}
using pg8::Gemm; using pg8::StaticOrder; using pg8::GroupedOrder; using pg8::gemm_phase;
#define GEMM_LDS(F) ((LAS unsigned char*)(F).lds)
template <class Epi> DI void run_gemm(const Ctx& F, const bf16_t* A, const bf16_t* Bt, int M, int N, int K, const Epi& E) {
    Gemm g{A, Bt, M, N, K}; StaticOrder S; S.init(M, N, F.G, F.bid);
    gemm_phase<Epi, StaticOrder, false>(GEMM_LDS(F), g, S, E, nullptr, F.wave);
}
constexpr int MOE_TAB = 131072;
template <class Epi> DI void run_moe_gemm(const Ctx& F, int l, const bf16_t* A, const bf16_t* Bt, int K, const Epi& E) {
    LAS int* ps = (LAS int*)(F.lds + MOE_TAB); LAS int* cnt = (LAS int*)(F.lds + MOE_TAB + 256); LAS int* tile_e = (LAS int*)(F.lds + MOE_TAB + 512);
    moe_prefix(F, l, ps, cnt);
    const int ntile = ps[32] >> 8;
    for (int t = F.tid; t < ntile; t += NTHREADS) { const int r = t << 8; int e = 0;
#pragma unroll 1
        for (int q = 1; q < 32; ++q) if (ps[q] <= r) e = q;
        tile_e[t] = e; }
    __syncthreads();
    Gemm g{A, Bt, MAXROWS, 1024, K}; GroupedOrder S{ntile, 4, F.G, F.bid, tile_e};
    gemm_phase<Epi, GroupedOrder, false>(GEMM_LDS(F), g, S, E, nullptr, F.wave);
}

__global__ void __launch_bounds__(NTHREADS, 2) mega_fwd(Params prm) {
    extern __shared__ __attribute__((aligned(16))) unsigned char lds_raw[];
    Ctx F; F.lds = (LAS unsigned char*)lds_raw; F.tid = threadIdx.x; F.lane = F.tid & 63; F.wave = __builtin_amdgcn_readfirstlane(F.tid >> 6); F.G = gridDim.x; F.bid = blockIdx.x; F.ws = F.wsp();
    if (F.tid == 0) *(LAS u32x4*)(F.lds + XB_LDS_OFF) = (u32x4){0u, 0u, 0u, 0u};
    __syncthreads();
    XcdBarrier bar = xcd_barrier_post((unsigned*)(F.ws + WS_CTL), (volatile LAS unsigned*)(F.lds + XB_LDS_OFF));
#define GRID_BAR() do { __syncthreads(); XcdBarrier b2 = bar; asm volatile("" : "+s"(b2.bar), "+s"(b2.x)); b2.bar = (unsigned*)(__attribute__((address_space(1))) unsigned*)b2.bar; xcd_barrier(b2); } while (0)

    phase_mod(F.fresh()); phase_tables(F.fresh()); phase_wconv(F.fresh(), 0);
    GRID_BAR();
    phase_u0(F.fresh());
    GRID_BAR();

#pragma unroll 1
    for (int l = 0; l < DEPTH; ++l) {
        const int kind = l % 3, jl = l / 3;
#define MK_ER() pg8::EpiResid{(l == 0) ? F.in(2) : F.HC(), (l == 0) ? F.in(0) : F.out(), F.HC(), F.out(), F.MOD() + (size_t)l * 17 * 6144, 2}
        if (kind == 0) {
            bf16_t* QKV = (bf16_t*)(F.S() + S_QKV); bf16_t* Ob = (bf16_t*)(F.S() + S_O);
            run_gemm(F.fresh(), F.U(), F.WMIX() + WM_RET_IN, NTOK, 4096, 1024, pg8::EpiRetQKV{QKV, F.RC(), F.RS()});
            GRID_BAR();
            phase_ret_scan(F.fresh(), jl);
            GRID_BAR();
            run_gemm(F.fresh(), F.U(), F.WMIX() + WM_RET_IN + (size_t)4096 * 1024, NTOK, 2048, 1024, pg8::EpiRetGate{Ob, (const float*)(F.ws + WS_STATS), F.in(10) + (size_t)jl * 2048});
            GRID_BAR();
            run_gemm(F.fresh(), Ob, F.WMIX() + WM_RET_OUT, NTOK, 1024, 2048, MK_ER());
            GRID_BAR();
        } else if (kind == 1) {
            run_gemm(F.fresh(), F.U(), F.WMIX() + WM_MLA_DOWN, NTOK, 768, 1024, pg8::EpiBf16Plain{(bf16_t*)(F.S() + S_DWN), 768});
            GRID_BAR();
            phase_mla_prep(F.fresh());
            GRID_BAR();
            run_gemm(F.fresh(), (const bf16_t*)(F.S() + S_DQ), F.WMIX() + WM_MLA_UQ, NTOK, 1536, 384, pg8::EpiBf16Plain{(bf16_t*)(F.S() + S_MQ), 1536});
            run_gemm(F.fresh(), (const bf16_t*)(F.S() + S_DKV), F.WMIX() + WM_MLA_UKV, NTOK, 2048, 256, pg8::EpiMlaKV{(bf16_t*)(F.S() + S_KK), (bf16_t*)(F.S() + S_VV)});
            GRID_BAR();
            phase_mla_attn(F.fresh());
            GRID_BAR();
            run_gemm(F.fresh(), (const bf16_t*)(F.S() + S_AO), F.WMIX() + WM_MLA_OUT, NTOK, 1024, 1024, MK_ER());
            GRID_BAR();
        } else {
            run_gemm(F.fresh(), F.U(), F.WMIX() + WM_CONV_IN, NTOK, 3072, 1024, pg8::EpiConvIn{(bf16_t*)(F.S() + S_GB), (bf16_t*)(F.S() + S_PB)});
            GRID_BAR();
            phase_conv(F.fresh());
            GRID_BAR();
            run_gemm(F.fresh(), (const bf16_t*)(F.S() + S_A2), F.WMIX() + WM_CONV_OUT, NTOK, 1024, 1024, MK_ER());
            GRID_BAR();
        }
        phase_ln1_router(F.fresh(), l);
        GRID_BAR();
        phase_moe_pos(F.fresh(), l);
        GRID_BAR();
        run_moe_gemm(F.fresh(), l, (const bf16_t*)(F.S() + S_XS), F.W13(), 1024, pg8::EpiMoe1{(bf16_t*)(F.S() + S_HDN)});
        GRID_BAR();
        run_moe_gemm(F.fresh(), l, (const bf16_t*)(F.S() + S_HDN), F.W2(), 512, pg8::EpiMoe2{(bf16_t*)(F.S() + S_YS), (const int*)(F.ws + WS_ROWTOK), (const float*)(F.ws + WS_ROWW)});
        GRID_BAR();
        phase_ln2(F.fresh(), l);
        if (l + 1 < DEPTH) { phase_wconv(F.fresh(), l + 1); GRID_BAR(); }
    }
}

extern "C" void kernel_launch(void* const* d_in, const int* in_sizes, int n_in, void* d_out, int out_size, void* d_ws, size_t ws_size, hipStream_t stream) {
    static int grid = 0;
    if (grid == 0) {
        if (n_in != 29 || out_size != NLAT * DM || ws_size < WS_END) { fprintf(stderr, "kernel_launch: unexpected shapes: n_in %d out %d ws %zu (need %zu)\n", n_in, out_size, ws_size, (size_t)WS_END); grid = -1; return; }
        int dev = 0, cus = 0, per_cu = 0;
        if (hipGetDevice(&dev) != hipSuccess || hipDeviceGetAttribute(&cus, hipDeviceAttributeMultiprocessorCount, dev) != hipSuccess) { grid = -1; return; }
        if (hipFuncSetAttribute((const void*)mega_fwd, hipFuncAttributeMaxDynamicSharedMemorySize, LDS_BYTES) != hipSuccess) { fprintf(stderr, "kernel_launch: hipFuncSetAttribute failed\n"); grid = -1; return; }
        if (hipOccupancyMaxActiveBlocksPerMultiprocessor(&per_cu, (const void*)mega_fwd, NTHREADS, LDS_BYTES) != hipSuccess || per_cu < 1) { fprintf(stderr, "kernel_launch: occupancy query says %d\n", per_cu); }
        (void)hipGetLastError();
        grid = cus;
    }
    if (grid < 0) return;
    (void)in_sizes;
    hipMemsetAsync((char*)d_ws + WS_CTL, 0, CTL_BYTES, stream);
    Params p{};
    for (int i = 0; i < 29; ++i) p.in[i] = (const float*)d_in[i];
    p.out = (float*)d_out; p.ws = (unsigned char*)d_ws;
    hipLaunchKernelGGL(mega_fwd, dim3(grid), dim3(NTHREADS), LDS_BYTES, stream, p);
}
```

```cpp
#ifndef PROBE_GROUP
#define PROBE_GROUP 0
#endif
#include <hip/hip_runtime.h>
#include <cstdio>
#include <cstdint>

#define DI __device__ __forceinline__
#define LAS __attribute__((address_space(3)))
#define PG8_LAS LAS
typedef unsigned short bf16_t;
typedef short bf16x8 __attribute__((ext_vector_type(8)));
typedef short s16x4 __attribute__((ext_vector_type(4)));
typedef float f32x4 __attribute__((ext_vector_type(4)));
typedef float f32x2 __attribute__((ext_vector_type(2)));
typedef float f32x8 __attribute__((ext_vector_type(8)));
typedef float f32x16 __attribute__((ext_vector_type(16)));
typedef unsigned u32x4 __attribute__((ext_vector_type(4)));
typedef int i32x4 __attribute__((ext_vector_type(4)));
typedef int i32x8 __attribute__((ext_vector_type(8)));
typedef unsigned u32x2 __attribute__((ext_vector_type(2)));

constexpr int DM = 1024, NB = 16, SEQ = 4096, CTXL = 256, DEPTH = 4;
constexpr int NCTX = NB * CTXL, NLAT = NB * SEQ, NTOK = NCTX + NLAT;
constexpr float ALPHA = 1.6817928305074292f;
constexpr float LN_EPS = 1e-5f, RMS_EPS = 1e-6f;
constexpr int NEXP = 32, MOE_H = 512;
constexpr int NSLOT = 2 * NTOK;
constexpr int MAXROWS = 147456;
constexpr int KVLEN = CTXL + SEQ;
constexpr int LDS_BYTES = 163840;
constexpr int XB_LDS_OFF = LDS_BYTES - 16;
constexpr int NTHREADS = 512;

constexpr size_t al256(size_t x) { return (x + 255) / 256 * 256; }
constexpr size_t WS_CTL   = 0;
constexpr size_t CTL_BYTES = 32768;
constexpr size_t CTL_GCOUNT = 16384;
constexpr size_t WS_MOD   = WS_CTL + CTL_BYTES;
constexpr size_t WS_ROPE  = al256(WS_MOD + (size_t)4 * 17 * 6144 * 4);
constexpr size_t WS_H16   = al256(WS_ROPE + (size_t)(2 * 4096 + 2 * 1024) * 4);
constexpr size_t WS_U     = al256(WS_H16 + (size_t)NTOK * DM * 2);
constexpr size_t WS_WMIX  = al256(WS_U + (size_t)NTOK * DM * 2);
constexpr size_t WMIX_ELEMS = (size_t)6144 * 1024 + (size_t)1024 * 2048;
constexpr size_t WS_W13   = al256(WS_WMIX + WMIX_ELEMS * 2);
constexpr size_t WS_W2    = al256(WS_W13 + (size_t)32 * 1024 * 1024 * 2);
constexpr size_t WS_SLOTE = al256(WS_W2 + (size_t)32 * 1024 * 512 * 2);
constexpr size_t WS_SLOTR = al256(WS_SLOTE + (size_t)NSLOT * 4);
constexpr size_t WS_SLOTW = al256(WS_SLOTR + (size_t)NSLOT * 4);
constexpr size_t WS_ROWTOK = al256(WS_SLOTW + (size_t)NSLOT * 4);
constexpr size_t WS_ROWW  = al256(WS_ROWTOK + (size_t)MAXROWS * 4);
constexpr size_t WS_STATS = al256(WS_ROWW + (size_t)MAXROWS * 4);
constexpr size_t WS_MR    = al256(WS_STATS + (size_t)NTOK * 4 * 16 * 4);
constexpr size_t WS_S     = al256(WS_MR + (size_t)NTOK * 4 * 2 * 4);
constexpr size_t S_QKV = 0;
constexpr size_t S_O   = (size_t)NTOK * 4096 * 2;
constexpr size_t S_RET_END = S_O + (size_t)NTOK * 2048 * 2;
constexpr size_t S_DWN = 0;
constexpr size_t S_DQ  = al256(S_DWN + (size_t)NTOK * 768 * 2);
constexpr size_t S_DKV = al256(S_DQ + (size_t)NTOK * 384 * 2);
constexpr size_t S_AO  = 0;
constexpr size_t S_MQ  = al256(S_DKV + (size_t)NTOK * 256 * 2);
constexpr size_t S_KK  = al256(S_MQ + (size_t)NTOK * 1536 * 2);
constexpr size_t S_VV  = al256(S_KK + (size_t)NB * 8 * KVLEN * 192 * 2);
constexpr size_t S_MLA_END = S_VV + (size_t)NB * 8 * KVLEN * 128 * 2;
static_assert(S_MQ >= (size_t)NTOK * 1024 * 2, "AO alias fits");
constexpr size_t S_PB = 0, S_GB = (size_t)NTOK * 1024 * 2, S_A2 = 2 * S_GB, S_CONV_END = 3 * S_GB;
constexpr size_t S_XS  = 0;
constexpr size_t S_HDN = (size_t)MAXROWS * 1024 * 2;
constexpr size_t S_YS  = S_HDN + (size_t)MAXROWS * 512 * 2;
constexpr size_t S_MOE_END = S_YS + (size_t)NSLOT * 1024 * 2;
constexpr size_t cmax(size_t a, size_t b) { return a > b ? a : b; }
constexpr size_t S_BYTES = cmax(cmax(S_RET_END, S_MLA_END), cmax(S_CONV_END, S_MOE_END));
constexpr size_t WS_END = WS_S + S_BYTES;

struct Params { const float* in[29]; float* out; unsigned char* ws; };

DI int lane_id_fresh() { int l; asm volatile("v_mbcnt_lo_u32_b32 %0, -1, 0\n\tv_mbcnt_hi_u32_b32 %0, -1, %0" : "=v"(l)); return l; }
DI float bf2f(unsigned short x) { return __uint_as_float(((unsigned)x) << 16); }
DI unsigned cvt_pk_bf16(float lo, float hi) { unsigned r; asm volatile("v_cvt_pk_bf16_f32 %0, %1, %2" : "=v"(r) : "v"(lo), "v"(hi)); return r; }
DI float bflo(unsigned w) { return __uint_as_float(w << 16); }
DI float bfhi(unsigned w) { return __uint_as_float(w & 0xffff0000u); }
DI float wave_sum(float v) {
#pragma unroll
    for (int m = 32; m >= 1; m >>= 1) v += __shfl_xor(v, m, 64);
    return v;
}
typedef _Float16 h16x4 __attribute__((ext_vector_type(4)));
DI u32x2 pack_h4(const f32x4& v) { const h16x4 h = __builtin_convertvector(v, h16x4); return __builtin_bit_cast(u32x2, h); }
DI f32x4 unpack_h4(const u32x2& w) { const h16x4 h = __builtin_bit_cast(h16x4, w); return __builtin_convertvector(h, f32x4); }
DI float silu_f(float a) { return a * __builtin_amdgcn_rcpf(1.0f + __expf(-a)); }
DI u32x4 pack8(const f32x4& a, const f32x4& b) { u32x4 w; w.x = cvt_pk_bf16(a[0], a[1]); w.y = cvt_pk_bf16(a[2], a[3]); w.z = cvt_pk_bf16(b[0], b[1]); w.w = cvt_pk_bf16(b[2], b[3]); return w; }
static_assert(WS_END <= 1287462016ull, "workspace budget (guaranteed >= sum of inputs = 1.287 GB)");
constexpr float FP8_SU = 8.0f;
constexpr float FP8_SW = 256.0f;
constexpr float FP8_SH = 8.0f;
DI unsigned pack_fp8x4(const f32x4& v) { int w = 0; w = __builtin_amdgcn_cvt_pk_fp8_f32(v[0], v[1], w, false); w = __builtin_amdgcn_cvt_pk_fp8_f32(v[2], v[3], w, true); return (unsigned)w; }
DI f32x4 clamp_fp8(const f32x4& v) { f32x4 r;
#pragma unroll
    for (int j = 0; j < 4; ++j) r[j] = __builtin_amdgcn_fmed3f(v[j], -440.0f, 440.0f);
    return r; }
#define XB_TMO      128
#define XB_XCNT(j)  (256  + 64 * (j))
#define XB_XSUB(j)  (1280 + 64 * (j))
#define XB_XGEN(j)  (2304 + 64 * (j))
#define XB_TOP      3328
#define XB_TOPGEN   3392
#define XCD_BAR_WORDS 3456
#define XB_SPIN_CAP (1u << 20)

__device__ __forceinline__ unsigned xb_ld(unsigned* p)              { return __hip_atomic_load((__attribute__((address_space(1))) unsigned*)p, __ATOMIC_RELAXED, __HIP_MEMORY_SCOPE_AGENT); }
__device__ __forceinline__ unsigned xb_add(unsigned* p, unsigned v) { return __hip_atomic_fetch_add((__attribute__((address_space(1))) unsigned*)p, v, __ATOMIC_RELAXED, __HIP_MEMORY_SCOPE_AGENT); }
__device__ __forceinline__ unsigned xb_xcc_id() { return (unsigned)__builtin_amdgcn_s_getreg((3 << 11) | 20) & 0xFu; }
#define XB_SPIN(cond, bar) do { unsigned _sp = 0; while (cond) { __builtin_amdgcn_s_sleep(1); \
    if ((++_sp & 255u) == 0u) { if (xb_ld(&(bar)[XB_TMO])) break; if (_sp > XB_SPIN_CAP) { atomicAdd(&(bar)[XB_TMO], 1u); break; } } } } while (0)

struct XcdBarrier {
    unsigned* bar; unsigned x;
    volatile LAS unsigned* st;
};

__device__ __forceinline__ XcdBarrier xcd_barrier_post(unsigned* bar, volatile LAS unsigned* st) {
    XcdBarrier b; b.bar = bar; b.x = xb_xcc_id(); b.st = st;
    if (threadIdx.x == 0) st[2] = xb_add(&bar[XB_XCNT(b.x)], 1u);
    return b;
}
__device__ __forceinline__ void xcd_barrier_complete(unsigned* bar, unsigned x, unsigned& nloc, unsigned& nx) {
    const unsigned G = gridDim.x * gridDim.y * gridDim.z;
    unsigned sum, cnt, mine, sp = 0u;
    for (;;) {
        sum = 0u; cnt = 0u; mine = 0u;
#pragma unroll
        for (unsigned j = 0; j < 16; ++j) { const unsigned c = xb_ld(&bar[XB_XCNT(j)]); sum += c; cnt += (c > 0u) ? 1u : 0u; mine = (j == x) ? c : mine; }
        if (sum == G) break;
        __builtin_amdgcn_s_sleep(1);
        if ((++sp & 255u) == 0u) { if (xb_ld(&bar[XB_TMO])) break; if (sp > XB_SPIN_CAP) { atomicAdd(&bar[XB_TMO], 1u); break; } }
    }
    nloc = mine > 0u ? mine : 1u; nx = cnt > 0u ? cnt : 1u;
}

__device__ __forceinline__ void xcd_barrier(const XcdBarrier& b) {
    asm volatile("s_waitcnt vmcnt(0)" ::: "memory");
    __syncthreads();
    if (threadIdx.x == 0) {
        unsigned* bar = b.bar;
        __builtin_amdgcn_s_waitcnt(0);
        unsigned nloc = b.st[0], nx = b.st[1];
        if (nloc == 0u) { xcd_barrier_complete(bar, b.x, nloc, nx); b.st[0] = nloc; b.st[1] = nx; }
        const unsigned old = xb_add(&bar[XB_XSUB(b.x)], 1u);
        const unsigned gen = old / nloc;
        if (old + 1u == (gen + 1u) * nloc) {
            __builtin_amdgcn_fence(__ATOMIC_RELEASE, "agent");
            asm volatile("s_waitcnt vmcnt(0)" ::: "memory");
            const unsigned og = xb_add(&bar[XB_TOP], 1u);
            const unsigned tg = og / nx;
            if (og + 1u == (tg + 1u) * nx) xb_add(&bar[XB_TOPGEN], 1u);
            else XB_SPIN(xb_ld(&bar[XB_TOPGEN]) == tg, bar);
            __builtin_amdgcn_fence(__ATOMIC_ACQUIRE, "agent");
            xb_add(&bar[XB_XGEN(b.x)], 1u);
            asm volatile("s_waitcnt vmcnt(0)" ::: "memory");
        } else {
            XB_SPIN(xb_ld(&bar[XB_XGEN(b.x)]) == gen, bar);
            __builtin_amdgcn_fence(__ATOMIC_ACQUIRE, "agent");
            asm volatile("s_waitcnt vmcnt(0)" ::: "memory");
        }
    }
    __syncthreads();
}
namespace pg8 {
constexpr int BM = 256, BK = 64, HALF = 128, HTB = HALF * BK * 2  , STAGE_BYTES = 8 * HTB, NXCD = 8, WGM = 8;

__host__ __device__ __forceinline__ int lds_byte(int r, int c) { const int st = (r >> 4) * 2 + (c >> 5), rr = r & 15, cc = c & 31, ob = rr * 64 + cc * 2; return st * 1024 + (ob ^ (((ob >> 9) & 1) << 5)); }
__host__ __device__ __forceinline__ void stage_rc(int b, int& R, int& C) { const int st = b / 1024, sb = b % 1024, swz = sb ^ (((sb >> 9) & 1) << 5); R = (st >> 1) * 16 + swz / 64; C = (st & 1) * 32 + (swz % 64) / 2; }
__host__ __device__ __forceinline__ int perm32(int rho) { const int n = rho >> 4, i = rho & 15; return 8 * (i >> 2) + 4 * n + (i & 3); }

struct Unit { int pm, pn; };
struct Gemm { const bf16_t* A; const bf16_t* Bt; int M, N, K; };

struct StaticOrder {
    int nM, nN, nwg, G, c, pm0 = 0;
    __host__ __device__ void init(int M, int N, int G_, int c_) { nM = M / BM; nN = N / BM; nwg = nM * nN; G = G_; c = c_; }
    __host__ __device__ bool next(int i, Unit& u) const {
        const long L = (long)i * G + c; if (L >= nwg) return false;
        int wgid = (int)L; { const int q = nwg / NXCD, r = nwg % NXCD, xcd = wgid % NXCD, off = wgid / NXCD; wgid = (xcd < r ? xcd * (q + 1) : r * (q + 1) + (xcd - r) * q) + off; }
        const int nig = WGM * nN, gid = wgid / nig, fm = gid * WGM, gsz = (nM - fm) < WGM ? (nM - fm) : WGM;
        u.pm = pm0 + fm + ((wgid % nig) % gsz); u.pn = (wgid % nig) / gsz; return true;
    }
    __device__ __forceinline__ void a_ready(const Unit&) const {}
    __device__ __forceinline__ void done(const Unit&) const {}
};
struct GroupedOrder {
    int ntile, ncol, G, c; const LAS int* tile_e; const LAS int* rowtab;
    __device__ __forceinline__ bool unit_of(int i, int& t, int& pl) const {
        if (G == 256 && ncol == 4) { const int x = c & 7, j = c >> 3; t = i * 64 + x * 8 + (j >> 2); pl = j & 3; return t < ntile; }
        const int L = i * G + c; t = L / ncol; pl = L - t * ncol; return L < ntile * ncol;
    }
    __device__ __forceinline__ bool next(int i, Unit& u) const { int t, pl; if (!unit_of(i, t, pl)) return false; u.pm = t; u.pn = tile_e[t] * ncol + pl; return true; }
    __device__ __forceinline__ void a_ready(const Unit&) const {}
    __device__ __forceinline__ void done(const Unit&) const {}
};

#define EPI_ARGS const f32x4 (&acc)[2][2][4][2], const Unit& u, int wr, int wc, int fr, int fq

struct EpiBf16Plain { static constexpr bool PERM = true, AFTER_DRAIN = false;
    bf16_t* O; int ldc;
    DI void operator()(EPI_ARGS) const {
        const int row0 = u.pm * BM + wr * 64 + fr, col0 = u.pn * BM + wc * 32 + 8 * fq;
#pragma unroll
        for (int ai = 0; ai < 2; ++ai)
#pragma unroll
            for (int m = 0; m < 4; ++m) { bf16_t* rowp = O + (size_t)(row0 + ai * HALF + m * 16) * ldc + col0;
#pragma unroll
                for (int bj = 0; bj < 2; ++bj) *(u32x4*)(rowp + bj * HALF) = pack8(acc[ai][bj][m][0], acc[ai][bj][m][1]); }
    }
};

struct EpiRetQKV { static constexpr bool PERM = true, AFTER_DRAIN = false;
    bf16_t* QKV; const float* RC; const float* RS;
    DI void operator()(EPI_ARGS) const {
        const int row0 = u.pm * BM + wr * 64 + fr, cb = wc * 32 + 8 * fq;
        const bool rope = (u.pn < 8) && (u.pm >= 16); const float ksc = (u.pn >= 4 && u.pn < 8) ? 0.0625f : 1.0f;
        const int f0 = (wc & 1) * 32 + 8 * fq;
        f32x4 c0[4], c1[4], s0[4], s1[4];
#define RQ_TAB(m, rowx) do { const int t = ((rowx) - NCTX) & 4095; const int p = (wc < 2) ? (t >> 6) : (t & 63); \
            c0[m] = *(const f32x4*)(RC + p * 64 + f0); c1[m] = *(const f32x4*)(RC + p * 64 + f0 + 4); s0[m] = *(const f32x4*)(RS + p * 64 + f0); s1[m] = *(const f32x4*)(RS + p * 64 + f0 + 4); } while (0)
        if (rope) {
#pragma unroll
            for (int m = 0; m < 4; ++m) RQ_TAB(m, row0 + m * 16);
        }
#pragma unroll
        for (int ai = 0; ai < 2; ++ai) {
#pragma unroll
            for (int m = 0; m < 4; ++m) {
                const int row = row0 + ai * HALF + m * 16; bf16_t* dst = QKV + (size_t)row * 4096 + u.pn * 256 + cb;
                f32x4 x1a = acc[ai][0][m][0], x1b = acc[ai][0][m][1], x2a = acc[ai][1][m][0], x2b = acc[ai][1][m][1];
                if (rope) {
                    const f32x4 o1a = x1a * c0[m] - x2a * s0[m], o1b = x1b * c1[m] - x2b * s1[m], o2a = x1a * s0[m] + x2a * c0[m], o2b = x1b * s1[m] + x2b * c1[m];
                    x1a = o1a; x1b = o1b; x2a = o2a; x2b = o2b;
                    if (ai == 0) RQ_TAB(m, row + HALF);
                }
                x1a *= ksc; x1b *= ksc; x2a *= ksc; x2b *= ksc;
                *(u32x4*)(dst) = pack8(x1a, x1b); *(u32x4*)(dst + HALF) = pack8(x2a, x2b);
            }
        }
#undef RQ_TAB
    }
};

struct EpiRetGate { static constexpr bool PERM = true, AFTER_DRAIN = false;
    bf16_t* O; const float* MR; const float* gn;
    DI void operator()(EPI_ARGS) const {
        const int row0 = u.pm * BM + wr * 64 + fr, col0 = u.pn * BM + wc * 32 + 8 * fq, head = u.pn >> 1;
        f32x4 gv[2][2];
#pragma unroll
        for (int bj = 0; bj < 2; ++bj)
#pragma unroll
            for (int n = 0; n < 2; ++n) gv[bj][n] = *(const f32x4*)(gn + col0 + bj * HALF + 4 * n);
        u32x4 ov[4][2]; f32x2 mr[4];
#pragma unroll
        for (int m = 0; m < 4; ++m) { const int row = row0 + m * 16; mr[m] = *(const f32x2*)(MR + ((size_t)row * 4 + head) * 2);
            ov[m][0] = *(const u32x4*)(O + (size_t)row * 2048 + col0); ov[m][1] = *(const u32x4*)(O + (size_t)row * 2048 + col0 + HALF); }
#pragma unroll
        for (int ai = 0; ai < 2; ++ai) {
#pragma unroll
            for (int m = 0; m < 4; ++m) {
                const int row = row0 + ai * HALF + m * 16; const float mean = mr[m][0], rstd = mr[m][1];
                bf16_t* rowp = O + (size_t)row * 2048 + col0;
                u32x4 res[2];
#pragma unroll
                for (int bj = 0; bj < 2; ++bj) {
                    const u32x4 w = ov[m][bj];
                    f32x4 o0, o1; o0[0] = bflo(w.x); o0[1] = bfhi(w.x); o0[2] = bflo(w.y); o0[3] = bfhi(w.y); o1[0] = bflo(w.z); o1[1] = bfhi(w.z); o1[2] = bflo(w.w); o1[3] = bfhi(w.w);
                    f32x4 r0, r1;
#pragma unroll
                    for (int j = 0; j < 4; ++j) { r0[j] = silu_f(acc[ai][bj][m][0][j]) * ((o0[j] - mean) * rstd * gv[bj][0][j]); r1[j] = silu_f(acc[ai][bj][m][1][j]) * ((o1[j] - mean) * rstd * gv[bj][1][j]); }
                    res[bj] = pack8(r0, r1);
                }
                if (ai == 0) { const int rown = row + HALF; mr[m] = *(const f32x2*)(MR + ((size_t)rown * 4 + head) * 2);
                    ov[m][0] = *(const u32x4*)(O + (size_t)rown * 2048 + col0); ov[m][1] = *(const u32x4*)(O + (size_t)rown * 2048 + col0 + HALF); }
                *(u32x4*)(rowp) = res[0]; *(u32x4*)(rowp + HALF) = res[1];
            }
        }
    }
};

struct EpiResid { static constexpr bool PERM = false, AFTER_DRAIN = false;
    const float* src_c; const float* src_l; float* dst_c; float* dst_l; const float* modl; int gchunk;
    DI void operator()(EPI_ARGS) const {
        const int row0 = u.pm * BM + wr * 64 + fr, col0 = u.pn * BM + wc * 32 + 4 * fq;
        const bool lat = u.pm >= 16; const int bp = lat ? ((u.pm - 16) >> 4) : 16;
        const float* gsrc = modl + (size_t)bp * 6144 + gchunk * 1024 + col0;
        const int rr0 = lat ? row0 - NCTX : row0;
        const float* hs = (lat ? src_l : src_c) + (size_t)rr0 * DM + col0; float* hd = (lat ? dst_l : dst_c) + (size_t)rr0 * DM + col0;
        f32x4 gv[2][2];
#pragma unroll
        for (int bj = 0; bj < 2; ++bj)
#pragma unroll
            for (int n = 0; n < 2; ++n) gv[bj][n] = *(const f32x4*)(gsrc + bj * HALF + n * 16);
#pragma unroll
        for (int ai = 0; ai < 2; ++ai) {
            f32x4 h[4][2][2];
#pragma unroll
            for (int m = 0; m < 4; ++m)
#pragma unroll
                for (int bj = 0; bj < 2; ++bj)
#pragma unroll
                    for (int n = 0; n < 2; ++n) h[m][bj][n] = *(const f32x4*)(hs + (size_t)(ai * HALF + m * 16) * DM + bj * HALF + n * 16);
#pragma unroll
            for (int m = 0; m < 4; ++m)
#pragma unroll
                for (int bj = 0; bj < 2; ++bj)
#pragma unroll
                    for (int n = 0; n < 2; ++n) *(f32x4*)(hd + (size_t)(ai * HALF + m * 16) * DM + bj * HALF + n * 16) = h[m][bj][n] * ALPHA + gv[bj][n] * acc[ai][bj][m][n];
        }
    }
};

struct EpiMlaKV { static constexpr bool PERM = true, AFTER_DRAIN = false;
    bf16_t* KK; bf16_t* VV;
    DI void operator()(EPI_ARGS) const {
        const int cb = wc * 32 + 8 * fq, h = u.pn; int b, pos0;
        if (u.pm >= 16) { const int t = u.pm - 16; b = t >> 4; pos0 = CTXL + (t & 15) * 256; } else { b = u.pm; pos0 = 0; }
        const size_t kv0 = (size_t)(b * 8 + h) * KVLEN + pos0 + wr * 64 + fr;
        bf16_t* kp = KK + kv0 * 192 + cb; bf16_t* vp = VV + kv0 * 128 + cb;
#pragma unroll
        for (int ai = 0; ai < 2; ++ai)
#pragma unroll
            for (int m = 0; m < 4; ++m) { const int ro = ai * HALF + m * 16;
                *(u32x4*)(kp + ro * 192) = pack8(acc[ai][0][m][0], acc[ai][0][m][1]);
                *(u32x4*)(vp + ro * 128) = pack8(acc[ai][1][m][0], acc[ai][1][m][1]); }
    }
};

struct EpiConvIn { static constexpr bool PERM = true, AFTER_DRAIN = false;
    bf16_t* GB; bf16_t* PB;
    DI void operator()(EPI_ARGS) const {
        const int row0 = u.pm * BM + wr * 64 + fr, cb = wc * 32 + 8 * fq;
#pragma unroll
        for (int ai = 0; ai < 2; ++ai)
#pragma unroll
            for (int m = 0; m < 4; ++m) {
                const int row = row0 + ai * HALF + m * 16;
                if (u.pn < 4) { bf16_t* rowp = GB + (size_t)row * DM + u.pn * 256 + cb;
                    *(u32x4*)(rowp) = pack8(acc[ai][0][m][0], acc[ai][0][m][1]); *(u32x4*)(rowp + HALF) = pack8(acc[ai][1][m][0], acc[ai][1][m][1]); }
                else { bf16_t* rowp = PB + (size_t)row * DM + (u.pn - 4) * 128 + cb;
                    *(u32x4*)(rowp) = pack8(acc[ai][0][m][0] * acc[ai][1][m][0], acc[ai][0][m][1] * acc[ai][1][m][1]); }
            }
    }
};

struct EpiMoe1 { static constexpr bool PERM = true, AFTER_DRAIN = false;
    unsigned char* HDN;
    DI void operator()(EPI_ARGS) const {
        const int row0 = u.pm * BM + wr * 64 + fr, cb = (u.pn & 3) * 128 + wc * 32 + 8 * fq;
        constexpr float inv = 1.0f / (FP8_SU * FP8_SW);
#pragma unroll
        for (int ai = 0; ai < 2; ++ai)
#pragma unroll
            for (int m = 0; m < 4; ++m) {
                const int row = row0 + ai * HALF + m * 16; f32x4 r0, r1;
#pragma unroll
                for (int j = 0; j < 4; ++j) { r0[j] = silu_f(acc[ai][0][m][0][j] * inv) * (acc[ai][1][m][0][j] * (inv * FP8_SH)); r1[j] = silu_f(acc[ai][0][m][1][j] * inv) * (acc[ai][1][m][1][j] * (inv * FP8_SH)); }
                u32x2 o; o.x = pack_fp8x4(clamp_fp8(r0)); o.y = pack_fp8x4(clamp_fp8(r1)); *(u32x2*)(HDN + (size_t)row * MOE_H + cb) = o;
            }
    }
};

struct EpiMoe2 { static constexpr bool PERM = true, AFTER_DRAIN = false;
    unsigned char* YS; const int* rowtok; const float* roww;
    const LAS int* slotL; const LAS float* wL; bool lds_ok;
    DI void operator()(EPI_ARGS) const {
        const int row0 = u.pm * BM + wr * 64 + fr, cb = (u.pn & 3) * 256 + wc * 32 + 8 * fq;
        int slot[2][4]; float w[2][4];
#pragma unroll
        for (int ai = 0; ai < 2; ++ai)
#pragma unroll
            for (int m = 0; m < 4; ++m) { const int row = row0 + ai * HALF + m * 16;
                if (lds_ok) { const int li = (u.pm >> 6) * 256 + wr * 64 + fr + ai * HALF + m * 16; slot[ai][m] = slotL[li]; w[ai][m] = wL[li]; }
                else { slot[ai][m] = rowtok[row]; w[ai][m] = roww[row] * (64.0f / (FP8_SH * FP8_SW)); } }
#pragma unroll
        for (int ai = 0; ai < 2; ++ai)
#pragma unroll
            for (int m = 0; m < 4; ++m) {
                if (slot[ai][m] >= 0) { unsigned char* rowp = YS + (size_t)slot[ai][m] * DM + cb;
#pragma unroll
                    for (int bj = 0; bj < 2; ++bj) { u32x2 o; o.x = pack_fp8x4(clamp_fp8(acc[ai][bj][m][0] * w[ai][m])); o.y = pack_fp8x4(clamp_fp8(acc[ai][bj][m][1] * w[ai][m])); *(u32x2*)(rowp + bj * HALF) = o; } }
            }
    }
};
template <class Epi, class Sched, bool STAMP = false, bool GATHER = false, bool FP8 = false>
__device__ __forceinline__ void gemm_phase(PG8_LAS unsigned char* lds, const Gemm g, const Sched& S, const Epi& E, unsigned long long* stamps, int wave_id) {
    int tid_l = lane_id_fresh(); asm volatile("" : "+v"(tid_l)); tid_l += 64 * wave_id;
    const int tid = tid_l, wid = __builtin_amdgcn_readfirstlane(tid >> 6), lane = tid & 63, wr = wid >> 2, wc = wid & 3, fr = lane & 15, fq = lane >> 4;
    const int K = g.K, nt = K / BK;
    int ts_lo = 0, ts_hi = 0, nts = 0; const unsigned long long rt_entry = STAMP ? (unsigned long long)wall_clock64() : 0ull;
#define PG8_STAMP() do { if (STAMP && wid == 0 && nts < 64) { const unsigned long long _c = (unsigned long long)clock64(); \
        ts_lo = (lane == nts) ? (int)(unsigned)_c : ts_lo; ts_hi = (lane == nts) ? (int)(unsigned)(_c >> 32) : ts_hi; ++nts; } } while (0)
    PG8_STAMP();
    unsigned voffA[2], voffB[2];
#pragma unroll
    for (int i = 0; i < 2; ++i) { int R, C; stage_rc(tid * 16 + i * 8192, R, C); const int Rb = Epi::PERM ? ((R & ~31) + perm32(R & 31)) : R;
        voffA[i] = (unsigned)(R * K + C) * 2u; voffB[i] = (unsigned)(Rb * K + C) * 2u; }
    unsigned offC[2][2], offN[2][2]; int gC[2];
    if constexpr (GATHER) {
#pragma unroll
        for (int i = 0; i < 2; ++i) { int R, C; stage_rc(tid * 16 + i * 8192, R, C); gC[i] = C * 2 | (R << 16); }
    }
#define PG8_GOFF(dst, ui_) do { _Pragma("unroll") for (int _h = 0; _h < 2; ++_h) _Pragma("unroll") for (int _i = 0; _i < 2; ++_i) \
        dst[_h][_i] = (unsigned)S.rowtab[(ui_) * 256 + _h * 128 + (gC[_i] >> 16)] * (unsigned)(K * 2) + (unsigned)(gC[_i] & 0xffff); } while (0)
    const size_t kstep = (size_t)(BK * 2);
    const size_t hstep = (size_t)HALF * K * 2;
    const size_t tstep = 2 * hstep;
    const unsigned ldsw = (unsigned)wid * 1024u;
    const int aoff = FP8 ? lds_byte(wr * 64 + fr, fq * 16) : lds_byte(wr * 64 + fr, fq * 8), boff = FP8 ? lds_byte(wc * 32 + fr, fq * 16) : lds_byte(wc * 32 + fr, fq * 8);
#define PG8_SA(b, h) (((b) * 2 + (h)) * HTB)
#define PG8_SB(b, h) ((4 + (b) * 2 + (h)) * HTB)
#define PG8_STAGE(bufoff, gbase, voff) do { _Pragma("unroll") for (int _i = 0; _i < 2; ++_i) \
        __builtin_amdgcn_global_load_lds((const unsigned*)((const char*)(gbase) + (voff)[_i]), (PG8_LAS unsigned*)(lds + (bufoff) + ldsw + _i * 8192), 16, 0, 0); } while (0)
#define PG8_STAGE_G(bufoff, kbase, offs) do { _Pragma("unroll") for (int _i = 0; _i < 2; ++_i) \
        __builtin_amdgcn_global_load_lds((const unsigned*)((const char*)(kbase) + (offs)[_i]), (PG8_LAS unsigned*)(lds + (bufoff) + ldsw + _i * 8192), 16, 0, 0); } while (0)
#define PG8_CAT8(lo, hi) __builtin_shufflevector(__builtin_bit_cast(i32x4, lo), __builtin_bit_cast(i32x4, hi), 0, 1, 2, 3, 4, 5, 6, 7)
#define PG8_LDA(dst, b, h) do { _Pragma("unroll") for (int m = 0; m < 4; ++m) _Pragma("unroll") for (int k = 0; k < 2; ++k) { if constexpr (FP8) { if (k == 0) dst##8[m] = PG8_CAT8(*(const PG8_LAS bf16x8*)(lds + PG8_SA(b, h) + aoff + m * 2048), *(const PG8_LAS bf16x8*)(lds + PG8_SA(b, h) + aoff + m * 2048 + 16)); } else dst[m][k] = *(const PG8_LAS bf16x8*)(lds + PG8_SA(b, h) + aoff + m * 2048 + k * 1024); } } while (0)
#define PG8_LDB(dst, b, h) do { _Pragma("unroll") for (int n = 0; n < 2; ++n) _Pragma("unroll") for (int k = 0; k < 2; ++k) { if constexpr (FP8) { if (k == 0) dst##8[n] = PG8_CAT8(*(const PG8_LAS bf16x8*)(lds + PG8_SB(b, h) + boff + n * 2048), *(const PG8_LAS bf16x8*)(lds + PG8_SB(b, h) + boff + n * 2048 + 16)); } else dst[n][k] = *(const PG8_LAS bf16x8*)(lds + PG8_SB(b, h) + boff + n * 2048 + k * 1024); } } while (0)
#define PG8_MMA(ai, bj, At, Bt) do { __builtin_amdgcn_s_setprio(1); \
        if constexpr (FP8) { _Pragma("unroll") for (int m = 0; m < 4; ++m) _Pragma("unroll") for (int n = 0; n < 2; ++n) \
            asm volatile("v_mfma_scale_f32_16x16x128_f8f6f4 %0, %1, %2, %0, %3, %3 op_sel_hi:[0,0,0]" : "+v"(acc[ai][bj][m][n]) : "v"(Bt##8[n]), "v"(At##8[m]), "v"(fp8_unit_scale)); } \
        else { _Pragma("unroll") for (int m = 0; m < 4; ++m) _Pragma("unroll") for (int n = 0; n < 2; ++n) _Pragma("unroll") for (int k = 0; k < 2; ++k) \
            acc[ai][bj][m][n] = __builtin_amdgcn_mfma_f32_16x16x32_bf16(Bt[n][k], At[m][k], acc[ai][bj][m][n], 0, 0, 0); } \
        __builtin_amdgcn_s_setprio(0); } while (0)
#define PG8_WAIT_V(n) asm volatile("s_waitcnt vmcnt(" #n ")" ::: "memory")
#define PG8_WAIT_L(n) asm volatile("s_waitcnt lgkmcnt(" #n ")" ::: "memory")
#define PG8_BAR __builtin_amdgcn_s_barrier()
#define PG8_SCHED __builtin_amdgcn_sched_barrier(0)
    Unit cur, nxt; int ui = 0;
    if (!S.next(0, cur)) return;
    f32x4 acc[2][2][4][2];
#pragma unroll
    for (int a = 0; a < 2; ++a)
#pragma unroll
        for (int b = 0; b < 2; ++b)
#pragma unroll
            for (int m = 0; m < 4; ++m)
#pragma unroll
                for (int n = 0; n < 2; ++n) acc[a][b][m][n] = (f32x4){0.f, 0.f, 0.f, 0.f};
    bf16x8 At[4][2], B0[2][2], B1[2][2]; i32x8 At8[4], B08[2], B18[2];
    int fp8_unit_scale = 0x7F7F7F7F; asm volatile("" : "+v"(fp8_unit_scale));
    const char* cA = (const char*)g.A + (size_t)cur.pm * tstep; const char* cB = (const char*)g.Bt + (size_t)cur.pn * tstep;
    S.a_ready(cur);
    const char* const gA = (const char*)g.A;
    if constexpr (GATHER) { PG8_GOFF(offC, 0); }
    PG8_STAGE(PG8_SB(0, 0), cB, voffB);
    if constexpr (GATHER) PG8_STAGE_G(PG8_SA(0, 0), gA, offC[0]); else PG8_STAGE(PG8_SA(0, 0), cA, voffA);
    PG8_STAGE(PG8_SB(0, 1), cB + hstep, voffB);
    if constexpr (GATHER) PG8_STAGE_G(PG8_SA(0, 1), gA, offC[1]); else PG8_STAGE(PG8_SA(0, 1), cA + hstep, voffA);
    if (wr == 1) PG8_BAR;
    PG8_WAIT_V(4); PG8_BAR;
    PG8_STAGE(PG8_SB(1, 0), cB + kstep, voffB);
    if constexpr (GATHER) PG8_STAGE_G(PG8_SA(1, 0), gA + kstep, offC[0]); else PG8_STAGE(PG8_SA(1, 0), cA + kstep, voffA);
    PG8_STAGE(PG8_SB(1, 1), cB + hstep + kstep, voffB);
    PG8_WAIT_V(6); PG8_BAR;
    PG8_STAMP();
    for (;;) {
        const bool has_next = S.next(ui + 1, nxt);
        const char* nA = has_next ? (const char*)g.A + (size_t)nxt.pm * tstep : cA; const char* nB = has_next ? (const char*)g.Bt + (size_t)nxt.pn * tstep : cB;
        for (int t = 0; t < nt; t += 2) {
            const bool last = (t == nt - 2);
            const char* a1 = cA + (size_t)(t + 1) * kstep;
            const char* a2 = last ? nA : cA + (size_t)(t + 2) * kstep; const char* b2 = last ? nB : cB + (size_t)(t + 2) * kstep;
            const char* a3 = a2 + kstep; const char* b3 = b2 + kstep;
            if (last && has_next) S.a_ready(nxt);
            const char* const g1 = gA + (size_t)(t + 1) * kstep; const char* const g2 = last ? gA : gA + (size_t)(t + 2) * kstep; const char* const g3 = g2 + kstep;
            if constexpr (GATHER) { if (last) { if (has_next) { PG8_GOFF(offN, ui + 1); } else {
                _Pragma("unroll") for (int _h = 0; _h < 2; ++_h) _Pragma("unroll") for (int _i = 0; _i < 2; ++_i) offN[_h][_i] = offC[_h][_i]; } } }
            unsigned oS0[2], oS1[2];
            if constexpr (GATHER) { _Pragma("unroll") for (int _i = 0; _i < 2; ++_i) { oS0[_i] = last ? offN[0][_i] : offC[0][_i]; oS1[_i] = last ? offN[1][_i] : offC[1][_i]; } }
            PG8_LDB(B0, 0, 0); PG8_SCHED; PG8_LDA(At, 0, 0); if constexpr (GATHER) PG8_STAGE_G(PG8_SA(1, 1), g1, offC[1]); else PG8_STAGE(PG8_SA(1, 1), a1 + hstep, voffA);
            PG8_WAIT_L(8); PG8_BAR; PG8_WAIT_L(0); PG8_MMA(0, 0, At, B0); PG8_BAR; PG8_SCHED;
            PG8_LDB(B1, 0, 1); PG8_STAGE(PG8_SB(0, 0), b2, voffB);
            PG8_BAR; PG8_WAIT_L(0); PG8_MMA(0, 1, At, B1); PG8_BAR;
            PG8_LDA(At, 0, 1); if constexpr (GATHER) PG8_STAGE_G(PG8_SA(0, 0), g2, oS0); else PG8_STAGE(PG8_SA(0, 0), a2, voffA);
            PG8_BAR; PG8_WAIT_L(0); PG8_MMA(1, 0, At, B0); PG8_BAR; PG8_SCHED;
            PG8_STAGE(PG8_SB(0, 1), b2 + hstep, voffB);
            PG8_WAIT_V(6); PG8_BAR; PG8_MMA(1, 1, At, B1); PG8_BAR;
            PG8_LDB(B0, 1, 0); PG8_SCHED; PG8_LDA(At, 1, 0); if constexpr (GATHER) PG8_STAGE_G(PG8_SA(0, 1), g2, oS1); else PG8_STAGE(PG8_SA(0, 1), a2 + hstep, voffA);
            PG8_WAIT_L(8); PG8_BAR; PG8_WAIT_L(0); PG8_MMA(0, 0, At, B0); PG8_BAR; PG8_SCHED;
            PG8_LDB(B1, 1, 1); PG8_STAGE(PG8_SB(1, 0), b3, voffB);
            PG8_BAR; PG8_WAIT_L(0); PG8_MMA(0, 1, At, B1); PG8_BAR;
            PG8_LDA(At, 1, 1); if constexpr (GATHER) PG8_STAGE_G(PG8_SA(1, 0), g3, oS0); else PG8_STAGE(PG8_SA(1, 0), a3, voffA);
            PG8_BAR; PG8_WAIT_L(0); PG8_MMA(1, 0, At, B0); PG8_BAR; PG8_SCHED;
            PG8_STAGE(PG8_SB(1, 1), b3 + hstep, voffB);
            PG8_WAIT_V(6); PG8_BAR; PG8_MMA(1, 1, At, B1); PG8_BAR;
        }
        PG8_STAMP();
        if constexpr (FP8) asm volatile("s_nop 7\n\ts_nop 7\n\ts_nop 3" ::: "memory");
        if constexpr (!Epi::AFTER_DRAIN) { E(acc, cur, wr, wc, fr, fq); S.done(cur); }
        PG8_STAMP();
        if (!has_next) break;
#pragma unroll
        for (int a = 0; a < 2; ++a)
#pragma unroll
            for (int b = 0; b < 2; ++b)
#pragma unroll
                for (int m = 0; m < 4; ++m)
#pragma unroll
                    for (int n = 0; n < 2; ++n) acc[a][b][m][n] = (f32x4){0.f, 0.f, 0.f, 0.f};
        cur = nxt; cA = nA; cB = nB; ++ui;
        if constexpr (GATHER) { _Pragma("unroll") for (int _h = 0; _h < 2; ++_h) _Pragma("unroll") for (int _i = 0; _i < 2; ++_i) offC[_h][_i] = offN[_h][_i]; }
    }
    PG8_WAIT_V(0);
    if (wr == 0) PG8_BAR;
    PG8_BAR;
    if constexpr (Epi::AFTER_DRAIN) { E.fused(acc, cur, wr, wc, fr, fq, lds, wid, lane); S.done(cur); }
    PG8_STAMP();
    if (STAMP && wid == 0) { stamps[lane] = lane < nts ? (((unsigned long long)(unsigned)ts_hi << 32) | (unsigned)ts_lo) : 0ull;
        if (lane == 62) stamps[62] = rt_entry; if (lane == 63) stamps[63] = (unsigned long long)wall_clock64(); }
#undef PG8_STAMP
#undef PG8_SA
#undef PG8_SB
#undef PG8_STAGE
#undef PG8_STAGE_G
#undef PG8_GOFF
#undef PG8_LDA
#undef PG8_LDB
#undef PG8_MMA
#undef PG8_CAT8
#undef PG8_WAIT_V
#undef PG8_WAIT_L
#undef PG8_BAR
#undef PG8_SCHED
}
}
struct Ctx {
    LAS unsigned char* lds; int tid, lane, wave, G, bid;
    unsigned char* ws;
    DI Ctx fresh() const { Ctx c = *this; int lid = lane_id_fresh(); int wv = wave, b = bid, g = G; asm volatile("" : "+v"(lid), "+s"(wv), "+s"(b), "+s"(g));
        c.tid = wv * 64 + lid; c.lane = lid; c.wave = wv; c.bid = b; c.G = g; return c; }
    DI const float* in(int i) const { return (const float*)(const __attribute__((address_space(1))) float*)P()->in[i]; }
    DI float* out() const { return (float*)(__attribute__((address_space(1))) float*)P()->out; }
    DI unsigned char* wsp() const { return (unsigned char*)(__attribute__((address_space(1))) unsigned char*)P()->ws; }
    DI const __attribute__((address_space(4))) Params* P() const { return (const __attribute__((address_space(4))) Params*)__builtin_amdgcn_kernarg_segment_ptr(); }
    DI float* MOD() const { return (float*)(ws + WS_MOD); }
    DI float* RC() const { return (float*)(ws + WS_ROPE); }
    DI float* RS() const { return RC() + 4096; }
    DI float* MC() const { return RC() + 8192; }
    DI float* MS() const { return RC() + 8192 + 1024; }
    DI bf16_t* H16() const { return (bf16_t*)(ws + WS_H16); }
    DI bf16_t* U() const { return (bf16_t*)(ws + WS_U); }
    DI bf16_t* WMIX() const { return (bf16_t*)(ws + WS_WMIX); }
    DI bf16_t* W13() const { return (bf16_t*)(ws + WS_W13); }
    DI bf16_t* W2() const { return (bf16_t*)(ws + WS_W2); }
    DI unsigned char* S() const { return ws + WS_S; }
};

DI void phase_mod(const Ctx& F) {
    LAS float* act = (LAS float*)F.lds;
    LAS float* red = act + 17 * 1024;
    const float* c = F.in(1); const float* cctx = F.in(3); const float* ada_w = F.in(4); const float* ada_b = F.in(5);
    for (int i = F.tid; i < 17 * 1024; i += NTHREADS) { const int b = i >> 10, k = i & 1023; const float x = b < 16 ? c[b * 1024 + k] : cctx[k]; act[i] = x / (1.0f + expf(-x)); }
    __syncthreads();
    for (int unit = F.bid; unit < 4 * 96; unit += F.G) {
        const int l = unit / 96, n0 = (unit % 96) * 64;
        const float* W = ada_w + (size_t)l * 1024 * 6144 + n0 + F.lane;
        float a[17];
#pragma unroll
        for (int b = 0; b < 17; ++b) a[b] = 0.f;
        const int k0 = F.wave * 128;
#pragma unroll 1
        for (int kb = 0; kb < 128; kb += 16) { float w[16];
#pragma unroll
            for (int k = 0; k < 16; ++k) w[k] = W[(size_t)(k0 + kb + k) * 6144];
#pragma unroll
            for (int k = 0; k < 16; ++k)
#pragma unroll
                for (int b = 0; b < 17; ++b) a[b] += act[b * 1024 + k0 + kb + k] * w[k]; }
#pragma unroll
        for (int b = 0; b < 17; ++b) red[(F.wave * 17 + b) * 64 + F.lane] = a[b];
        __syncthreads();
        for (int i = F.tid; i < 17 * 64; i += NTHREADS) { const int b = i >> 6, n = i & 63; float s = ada_b[l * 6144 + n0 + n];
#pragma unroll
            for (int w = 0; w < 8; ++w) s += red[(w * 17 + b) * 64 + n];
            F.MOD()[((size_t)l * 17 + b) * 6144 + n0 + n] = s; }
        __syncthreads();
    }
}

DI void sincos_d(double a, double& s, double& c) {
    const double TWO_PI = 6.283185307179586476925286766559;
    const double n = rint(a / TWO_PI); const double r = a - n * TWO_PI;
    const double r2 = r * r; double ts = 1.0, tc = 1.0, ss = 1.0, cc = 1.0;
#pragma unroll
    for (int k = 1; k <= 16; ++k) { tc *= -r2 / (double)((2 * k - 1) * (2 * k)); cc += tc; ts *= -r2 / (double)((2 * k) * (2 * k + 1)); ss += ts; }
    s = r * ss; c = cc;
}
DI void phase_tables(const Ctx& F) {
    const int gt = F.bid * NTHREADS + F.tid, gs = F.G * NTHREADS;
    const double LN1E4 = 9.210340371976182736071965818737;
    for (int i = gt; i < 4096; i += gs) { const int p = i >> 6, f = i & 63; const double a = (double)p * exp(-LN1E4 * (double)f / 64.0); double s, c; sincos_d(a, s, c); F.RC()[i] = (float)c; F.RS()[i] = (float)s; }
    for (int i = gt; i < 1024; i += gs) { const int p = i >> 4, f = i & 15; const double a = (double)p * exp(-LN1E4 * (double)f / 16.0); double s, c; sincos_d(a, s, c); F.MC()[i] = (float)c; F.MS()[i] = (float)s; }
}

struct MapId   { const float* src; int ld; DI const float* col(int n0) const { return src + n0; } };
struct MapPad  { const float* src; int ld; int nvalid; DI const float* col(int n0) const { return n0 < nvalid ? src + n0 : nullptr; } };
struct MapConvIn { const float* src; int ld; DI const float* col(int n0) const { if (n0 < 1024) return src + n0; const int q = n0 - 1024, p = q >> 8, half = (q >> 7) & 1, i = q & 127; return src + 1024 + half * 1024 + p * 128 + i; } };
struct MapW13  { const float* w1; const float* w3; int ld; DI const float* col(int n0) const { const int e = n0 >> 10, nn = n0 & 1023, p = nn >> 8, half = (nn >> 7) & 1, i = nn & 127; return w1 + (ptrdiff_t)half * (w3 - w1) + (size_t)e * 1024 * 512 + p * 128 + i; } };
struct MapW2   { const float* w2; int ld; DI const float* col(int n0) const { const int e = n0 >> 10, nn = n0 & 1023; return w2 + (size_t)e * 512 * 1024 + nn; } };
template <bool FP8, class Map> DI void wconv_job2(const Ctx& F, const Map& mp, int K, int Ndst, unsigned char* dst, float wscale = 1.0f) {
    constexpr int KT = FP8 ? 128 : 64, NTL = FP8 ? 128 : 256, P1 = NTL + 4, TPR = NTL / 4, RPP = NTHREADS / TPR, ES = FP8 ? 1 : 2, NW = FP8 ? 2 : 4;
    LAS float* tile = (LAS float*)F.lds; LAS unsigned char* st2 = F.lds + KT * P1 * 4;
    const int ntk = K / KT, nt = (Ndst / NTL) * ntk;
    const int n4 = (F.tid % TPR) * 4, kr = F.tid / TPR, an = F.tid % NTL, akq = F.tid / NTL;
    const size_t rowb = (size_t)K * ES;
    f32x4 v[8];
#define WC_LOADS(t_) do { const int tn_ = (t_) / ntk, tk_ = (t_) - tn_ * ntk; const float* src_ = mp.col(tn_ * NTL + (n4 & ~63)); \
        _Pragma("unroll") for (int it = 0; it < 8; ++it) v[it] = src_ ? *(const f32x4*)(src_ + (size_t)(tk_ * KT + it * RPP + kr) * mp.ld + (n4 & 63)) : (f32x4){0.f, 0.f, 0.f, 0.f}; } while (0)
    int t = F.bid;
    if (t < nt) WC_LOADS(t);
    for (; t < nt; t += F.G) {
        const int tn = t / ntk, tk = t - tn * ntk, n0 = tn * NTL, k0 = tk * KT;
#pragma unroll
        for (int it = 0; it < 8; ++it) *(LAS f32x4*)(tile + (it * RPP + kr) * P1 + n4) = v[it];
        __syncthreads();
        if (t + F.G < nt) WC_LOADS(t + F.G);
        {   const LAS float* tp = tile + (akq * 32) * P1 + an; u32x4 w[NW];
            if constexpr (FP8) {
#pragma unroll
                for (int q = 0; q < 8; ++q) { f32x4 a; a[0] = tp[(4 * q) * P1] * FP8_SW; a[1] = tp[(4 * q + 1) * P1] * FP8_SW; a[2] = tp[(4 * q + 2) * P1] * FP8_SW; a[3] = tp[(4 * q + 3) * P1] * FP8_SW; w[q >> 2][q & 3] = pack_fp8x4(clamp_fp8(a)); }
            } else {
#pragma unroll
                for (int q = 0; q < 16; ++q) w[q >> 2][q & 3] = cvt_pk_bf16(tp[(2 * q) * P1] * wscale, tp[(2 * q + 1) * P1] * wscale);
            }
#pragma unroll
            for (int i = 0; i < NW; ++i) *(LAS u32x4*)(st2 + an * 144 + akq * (32 * ES) + i * 16) = w[i];
        }
        __syncthreads();
#pragma unroll
        for (int it = 0; it < NTL / 64; ++it) { const int row = it * 64 + (F.tid >> 3), ch = F.tid & 7;
            *(u32x4*)(dst + (size_t)(n0 + row) * rowb + (size_t)k0 * ES + ch * 16) = *(const LAS u32x4*)(st2 + row * 144 + ch * 16); }
    }
#undef WC_LOADS
    __syncthreads();
}
template <class Map> DI void wconv_job(const Ctx& F, const Map& mp, int K, int Ndst, bf16_t* dst, float wscale = 1.0f) { wconv_job2<false>(F, mp, K, Ndst, (unsigned char*)dst, wscale); }
template <class Map> DI void wconv_job_fp8(const Ctx& F, const Map& mp, int K, int Ndst, unsigned char* dst) { wconv_job2<true>(F, mp, K, Ndst, dst); }
constexpr size_t WM_RET_IN = 0, WM_RET_OUT = (size_t)6144 * 1024;
constexpr size_t WM_MLA_DOWN = 0, WM_MLA_UQ = (size_t)768 * 1024, WM_MLA_UKV = WM_MLA_UQ + (size_t)1536 * 384, WM_MLA_OUT = WM_MLA_UKV + (size_t)2048 * 256;
constexpr size_t WM_CONV_IN = 0, WM_CONV_OUT = (size_t)3072 * 1024;
DI void phase_wconv(const Ctx& F, int l) {
    const int kind = l % 3, j = l / 3;
    if (kind == 0) {
        wconv_job(F, MapId{F.in(8) + (size_t)j * 1024 * 6144, 6144}, 1024, 6144, F.WMIX() + WM_RET_IN);
        wconv_job(F, MapId{F.in(11) + (size_t)j * 2048 * 1024, 1024}, 2048, 1024, F.WMIX() + WM_RET_OUT);
    } else if (kind == 1) {
        wconv_job(F, MapPad{F.in(12), 704, 704}, 1024, 768, F.WMIX() + WM_MLA_DOWN);
        wconv_job(F, MapId{F.in(15), 1536}, 384, 1536, F.WMIX() + WM_MLA_UQ, 0.07216878364870322f * 1.4426950408889634f);
        wconv_job(F, MapId{F.in(16), 2048}, 256, 2048, F.WMIX() + WM_MLA_UKV);
        wconv_job(F, MapId{F.in(17), 1024}, 1024, 1024, F.WMIX() + WM_MLA_OUT);
    } else {
        wconv_job(F, MapConvIn{F.in(18), 3072}, 1024, 3072, F.WMIX() + WM_CONV_IN);
        wconv_job(F, MapId{F.in(21), 1024}, 1024, 1024, F.WMIX() + WM_CONV_OUT);
    }
    wconv_job_fp8(F, MapW13{F.in(26) + (size_t)l * 32 * 1024 * 512, F.in(27) + (size_t)l * 32 * 1024 * 512, 512}, 1024, 32 * 1024, (unsigned char*)F.W13());
    wconv_job_fp8(F, MapW2{F.in(28) + (size_t)l * 32 * 512 * 1024, 1024}, 512, 32 * 1024, (unsigned char*)F.W2());
}

DI const float* xrow(const Ctx& F, int row) { return row < NCTX ? F.in(2) + (size_t)row * DM : F.in(0) + (size_t)(row - NCTX) * DM; }
DI int row_bp(int row) { return row < NCTX ? 16 : ((row - NCTX) >> 12); }

DI void phase_u0(const Ctx& F) {
    const float* mod0 = F.MOD();
    const int c0 = (F.tid & 127) * 8;
#define U0_LOAD(H0, H1, rb_) do { _Pragma("unroll") for (int j = 0; j < 4; ++j) { const int row = (rb_) + j * F.G * 4; if (row < NTOK) { const float* h = xrow(F, row) + c0; H0[j] = *(const f32x4*)h; H1[j] = *(const f32x4*)(h + 4); } } } while (0)
#define U0_PROC(H0, H1, rb_) do { _Pragma("unroll") for (int j = 0; j < 4; ++j) { const int row = (rb_) + j * F.G * 4; if (row < NTOK) { const float* m = mod0 + (size_t)row_bp(row) * 6144 + c0; \
            const f32x4 sh0 = *(const f32x4*)m, sh1 = *(const f32x4*)(m + 4), sc0 = *(const f32x4*)(m + 1024), sc1 = *(const f32x4*)(m + 1028); \
            *(u32x4*)(F.U() + (size_t)row * DM + c0) = pack8(H0[j] * (sc0 + 1.0f) + sh0, H1[j] * (sc1 + 1.0f) + sh1); \
            const u32x2 a = pack_h4(H0[j]), b = pack_h4(H1[j]); u32x4 w; w.x = a.x; w.y = a.y; w.z = b.x; w.w = b.y; *(u32x4*)(F.H16() + (size_t)row * DM + c0) = w; } } } while (0)
    f32x4 a0[4], a1[4], b0[4], b1[4];
    const int step = F.G * 16;
    int rb = F.bid * 4 + (F.tid >> 7);
    U0_LOAD(a0, a1, rb);
    for (; rb < NTOK; rb += 2 * step) {
        U0_LOAD(b0, b1, rb + step);
        U0_PROC(a0, a1, rb);
        U0_LOAD(a0, a1, rb + 2 * step);
        U0_PROC(b0, b1, rb + step);
    }
#undef U0_LOAD
#undef U0_PROC
}

constexpr int RT_VT = 0;
constexpr int RT_VSTRIDE = 1032;
constexpr int RT_RED = RT_VT + 16 * RT_VSTRIDE * 2;
constexpr int RT_LG = RT_RED + 8 * 16 * 48 * 4;
constexpr int RT_HIST = RT_LG + 16 * 36 * 4, RT_BASE = RT_HIST + 128, RT_INFO = RT_BASE + 128, RT_VEC = RT_INFO + 544 * 4, RT_END = RT_VEC + 5 * 4096;
static_assert(RT_END <= XB_LDS_OFF - 16, "router LDS");
constexpr int ROWS_PER_BLOCK = NTOK / 256;
static_assert(ROWS_PER_BLOCK * 256 == NTOK && ROWS_PER_BLOCK % 16 == 0, "row split");
DI void phase_ln1_router(const Ctx& F, int l, const bf16_t* Y, int r0, int rpb) {
    LAS _Float16* Vt = (LAS _Float16*)(F.lds + RT_VT); LAS float* red = (LAS float*)(F.lds + RT_RED); LAS float* lgs = (LAS float*)(F.lds + RT_LG);
    LAS unsigned* hist = (LAS unsigned*)(F.lds + RT_HIST); LAS unsigned* base = (LAS unsigned*)(F.lds + RT_BASE); LAS unsigned* rinfo = (LAS unsigned*)(F.lds + RT_INFO);
    const float* wg = F.in(22) + (size_t)l * 1024 * 4; const float* bg = F.in(23) + l * 4; const float* we = F.in(24) + (size_t)l * 1024 * 32; const float* be = F.in(25) + l * 32;
    if (F.tid < 32) hist[F.tid] = 0u;
    typedef _Float16 h16x8 __attribute__((ext_vector_type(8)));
    h16x8 wreg[4][3];
    {   const int col = F.lane & 15, kq = F.lane >> 4;
#pragma unroll
        for (int s = 0; s < 4; ++s)
#pragma unroll
            for (int ct = 0; ct < 3; ++ct) { const int e = 16 * ct + col;
#pragma unroll
                for (int jj = 0; jj < 8; ++jj) { const int k = F.wave * 128 + 32 * s + 8 * kq + jj; wreg[s][ct][jj] = (_Float16)(e < 4 ? wg[k * 4 + e] : (e < 36 ? we[k * 32 + (e - 4)] : 0.f)); } } }
    const float* lng = F.in(6) + (size_t)(l * 2 + 0) * DM; const float* lnb = F.in(7) + (size_t)(l * 2 + 0) * DM;
    const float* modl = F.MOD() + (size_t)l * 17 * 6144;
    int* slot_e = (int*)(F.ws + WS_SLOTE); int* slot_r = (int*)(F.ws + WS_SLOTR); float* slot_w = (float*)(F.ws + WS_SLOTW);
    unsigned* gcount = (unsigned*)(F.ws + WS_CTL + CTL_GCOUNT) + l * 32;
    const int rblk = r0 + F.bid * rpb;
    LAS float* vec = (LAS float*)(F.lds + RT_VEC);
    int bp_cur = row_bp(rblk);
    for (int i = F.tid; i < 1024; i += NTHREADS) { vec[i] = lng[i]; vec[1024 + i] = lnb[i]; const float* m = modl + (size_t)bp_cur * 6144; vec[2048 + i] = m[2 * 1024 + i]; vec[3072 + i] = m[3 * 1024 + i]; vec[4096 + i] = m[4 * 1024 + i]; }
    u32x2 zpre[2][4], ypre[2][4];
#pragma unroll
    for (int rr = 0; rr < 2; ++rr) { const int row = rblk + F.wave * 2 + rr; const bf16_t* hp = F.H16() + (size_t)row * DM + F.lane * 4; const bf16_t* yp = Y + (size_t)row * DM + F.lane * 4;
#pragma unroll
        for (int j = 0; j < 4; ++j) { zpre[rr][j] = *(const u32x2*)(hp + 256 * j); ypre[rr][j] = *(const u32x2*)(yp + 256 * j); } }
    __syncthreads();
#pragma unroll 1
    for (int grp = 0; grp < rpb / 16; ++grp) {
        {   const int bpg = row_bp(rblk + grp * 16);
            if (bpg != bp_cur) {
                bp_cur = bpg; __syncthreads();
                for (int i = F.tid; i < 1024; i += NTHREADS) { const float* m = modl + (size_t)bp_cur * 6144; vec[2048 + i] = m[2 * 1024 + i]; vec[3072 + i] = m[3 * 1024 + i]; vec[4096 + i] = m[4 * 1024 + i]; }
                __syncthreads();
            }
            f32x4 z[2][4]; float s[2] = {0.f, 0.f};
#pragma unroll
            for (int rr = 0; rr < 2; ++rr)
#pragma unroll
                for (int j = 0; j < 4; ++j) { const f32x4 gt = *(const LAS f32x4*)(vec + 2048 + F.lane * 4 + 256 * j); const u32x2 yw = ypre[rr][j];
                    f32x4 y; y[0] = bflo(yw.x); y[1] = bfhi(yw.x); y[2] = bflo(yw.y); y[3] = bfhi(yw.y);
                    const f32x4 hh = unpack_h4(zpre[rr][j]);
                    z[rr][j] = hh * ALPHA + gt * y; s[rr] += (z[rr][j][0] + z[rr][j][1]) + (z[rr][j][2] + z[rr][j][3]); }
            if (grp + 1 < rpb / 16) {
#pragma unroll
                for (int rr = 0; rr < 2; ++rr) { const int row = rblk + (grp + 1) * 16 + F.wave * 2 + rr; const bf16_t* hp = F.H16() + (size_t)row * DM + F.lane * 4; const bf16_t* yp = Y + (size_t)row * DM + F.lane * 4;
#pragma unroll
                    for (int j = 0; j < 4; ++j) { zpre[rr][j] = *(const u32x2*)(hp + 256 * j); ypre[rr][j] = *(const u32x2*)(yp + 256 * j); } }
            }
#pragma unroll
            for (int m = 32; m >= 1; m >>= 1) { s[0] += __shfl_xor(s[0], m, 64); s[1] += __shfl_xor(s[1], m, 64); }
            float s2[2] = {0.f, 0.f};
#pragma unroll
            for (int rr = 0; rr < 2; ++rr) { const float mean = s[rr] * (1.0f / 1024.0f);
#pragma unroll
                for (int j = 0; j < 4; ++j) { z[rr][j] -= mean; s2[rr] += (z[rr][j][0] * z[rr][j][0] + z[rr][j][1] * z[rr][j][1]) + (z[rr][j][2] * z[rr][j][2] + z[rr][j][3] * z[rr][j][3]); } }
#pragma unroll
            for (int m = 32; m >= 1; m >>= 1) { s2[0] += __shfl_xor(s2[0], m, 64); s2[1] += __shfl_xor(s2[1], m, 64); }
#pragma unroll
            for (int rr = 0; rr < 2; ++rr) {
                const int rg = F.wave * 2 + rr, row = rblk + grp * 16 + rg; const float rstd = rsqrtf(s2[rr] * (1.0f / 1024.0f) + LN_EPS);
                bf16_t* hp = F.H16() + (size_t)row * DM + F.lane * 4;
#pragma unroll
                for (int j = 0; j < 4; ++j) { const int c = F.lane * 4 + 256 * j;
                    const f32x4 h = z[rr][j] * rstd * *(const LAS f32x4*)(vec + c) + *(const LAS f32x4*)(vec + 1024 + c);
                    *(u32x2*)(hp + 256 * j) = pack_h4(h);
                    const f32x4 sh = *(const LAS f32x4*)(vec + 3072 + c), sc = *(const LAS f32x4*)(vec + 4096 + c); const f32x4 v = h * (sc + 1.0f) + sh;
                    *(unsigned*)((unsigned char*)F.U() + (size_t)row * DM + c) = pack_fp8x4(clamp_fp8(v * FP8_SU));
                    *(LAS u32x2*)(Vt + rg * RT_VSTRIDE + c) = pack_h4(v); }
            }
        }
        __syncthreads();
        {   f32x4 acc[3];
#pragma unroll
            for (int ct = 0; ct < 3; ++ct) acc[ct] = (f32x4){0.f, 0.f, 0.f, 0.f};
            const LAS _Float16* ap = Vt + (F.lane & 15) * RT_VSTRIDE + F.wave * 128 + 8 * (F.lane >> 4);
#pragma unroll
            for (int s = 0; s < 4; ++s) { const h16x8 a = *(const LAS h16x8*)(ap + 32 * s);
#pragma unroll
                for (int ct = 0; ct < 3; ++ct) acc[ct] = __builtin_amdgcn_mfma_f32_16x16x32_f16(a, wreg[s][ct], acc[ct], 0, 0, 0); }
#pragma unroll
            for (int ct = 0; ct < 3; ++ct)
#pragma unroll
                for (int r = 0; r < 4; ++r) red[(F.wave * 16 + 4 * (F.lane >> 4) + r) * 48 + 16 * ct + (F.lane & 15)] = acc[ct][r];
        }
        __syncthreads();
        for (int i = F.tid; i < 16 * 36; i += NTHREADS) { const int r = i / 36, e = i - r * 36; float s = e < 4 ? bg[e] : be[e - 4];
#pragma unroll
            for (int w = 0; w < 8; ++w) s += red[(w * 16 + r) * 48 + e];
            lgs[i] = s; }
        __syncthreads();
        if (F.tid < 16) {
            const int rg = F.tid, row = rblk + grp * 16 + rg; const LAS float* lg = lgs + rg * 36;
            int gi = 0; float gm = lg[0];
            for (int g = 1; g < 4; ++g) if (lg[g] > gm) { gm = lg[g]; gi = g; }
            float gden = 0.f;
            for (int g = 0; g < 4; ++g) gden += expf(lg[g] - gm);
            const float gp = 1.0f / gden;
            const LAS float* el = lg + 4 + gi * 8;
            int e0 = 0; float m0 = el[0];
            for (int q = 1; q < 8; ++q) if (el[q] > m0) { m0 = el[q]; e0 = q; }
            int e1 = -1; float m1 = -3.0e38f;
            for (int q = 0; q < 8; ++q) if (q != e0 && el[q] > m1) { m1 = el[q]; e1 = q; }
            const float t = expf(m1 - m0); const float w0 = gp / (1.0f + t), w1 = gp * t / (1.0f + t);
            const int ex0 = gi * 8 + e0, ex1 = gi * 8 + e1, rl = grp * 16 + rg;
            const unsigned r0 = atomicAdd((unsigned*)&hist[ex0], 1u); const unsigned r1 = atomicAdd((unsigned*)&hist[ex1], 1u);
            rinfo[rl * 2 + 0] = ((unsigned)ex0 << 24) | r0; rinfo[rl * 2 + 1] = ((unsigned)ex1 << 24) | r1;
            slot_w[(size_t)row * 2 + 0] = w0; slot_w[(size_t)row * 2 + 1] = w1;
        }
    }
    __syncthreads();
    if (F.tid < 32) base[F.tid] = atomicAdd(&gcount[F.tid], hist[F.tid]);
    __syncthreads();
    for (int i = F.tid; i < rpb * 2; i += NTHREADS) { const unsigned ri = rinfo[i]; const int e = (int)(ri >> 24); slot_e[(size_t)rblk * 2 + i] = e; slot_r[(size_t)rblk * 2 + i] = (int)(base[e] + (ri & 0xffffffu)); }
    __syncthreads();
}

DI void moe_prefix(const Ctx& F, int l, LAS int* ps  , LAS int* cnt  ) {
    const unsigned* gcount = (const unsigned*)(F.ws + WS_CTL + CTL_GCOUNT) + l * 32;
    if (F.tid < 64) {
        const int L = F.tid; const int c = L < 32 ? (int)__hip_atomic_load(&gcount[L & 31], __ATOMIC_RELAXED, __HIP_MEMORY_SCOPE_AGENT) : 0;
        const int pad = (c + 255) / 256 * 256; int inc = pad;
#pragma unroll
        for (int d = 1; d < 32; d <<= 1) { const int v = __shfl_up(inc, d, 64); if (L >= d) inc += v; }
        if (L < 32) { cnt[L] = c; ps[L] = inc - pad; if (L == 31) ps[32] = inc; }
    }
    __syncthreads();
}
DI void phase_moe_pos(const Ctx& F, int l, int r0) {
    LAS int* ps = (LAS int*)F.lds; LAS int* cnt = ps + 64;
    moe_prefix(F, l, ps, cnt);
    const int* slot_e = (const int*)(F.ws + WS_SLOTE); const int* slot_r = (const int*)(F.ws + WS_SLOTR); const float* slot_w = (const float*)(F.ws + WS_SLOTW);
    int* rowtok = (int*)(F.ws + WS_ROWTOK); float* roww = (float*)(F.ws + WS_ROWW);
    if (F.bid < 32) { const int e = F.bid; const int pe = (cnt[e] + 255) / 256 * 256; for (int i = cnt[e] + F.tid; i < pe; i += NTHREADS) rowtok[ps[e] + i] = -1; }
    for (int sl = 2 * r0 + F.bid * NTHREADS + F.tid; sl < NSLOT; sl += F.G * NTHREADS) { const int dest = ps[slot_e[sl]] + slot_r[sl]; rowtok[dest] = sl; roww[dest] = slot_w[sl]; }
}

DI void phase_ln2(const Ctx& F, int l, int r0, int rpb) {
    LAS float* vec = (LAS float*)F.lds;
    const float* lng = F.in(6) + (size_t)(l * 2 + 1) * DM; const float* lnb = F.in(7) + (size_t)(l * 2 + 1) * DM;
    const float* modl = F.MOD() + (size_t)l * 17 * 6144; const float* modn = F.MOD() + (size_t)(l + 1 < DEPTH ? l + 1 : l) * 17 * 6144;
    const unsigned char* YS = (const unsigned char*)(F.S() + S_YS);
    const bool has_next = (l + 1 < DEPTH);
    const int rblk = r0 + F.bid * rpb;
    int bp_cur = row_bp(rblk);
    for (int i = F.tid; i < 1024; i += NTHREADS) { vec[i] = lng[i]; vec[1024 + i] = lnb[i]; vec[2048 + i] = modl[(size_t)bp_cur * 6144 + 5 * 1024 + i]; vec[3072 + i] = modn[(size_t)bp_cur * 6144 + i]; vec[4096 + i] = modn[(size_t)bp_cur * 6144 + 1024 + i]; }
    u32x2 hpre[2][4]; unsigned y0p[2][4], y1p[2][4];
#define LN2_LOAD(grp_) do { _Pragma("unroll") for (int rr = 0; rr < 2; ++rr) { const int row = rblk + (grp_) * 16 + F.wave * 2 + rr; const bf16_t* hp = F.H16() + (size_t)row * DM + F.lane * 4; const unsigned char* y0 = YS + (size_t)row * 2 * DM + F.lane * 4; \
        _Pragma("unroll") for (int j = 0; j < 4; ++j) { hpre[rr][j] = *(const u32x2*)(hp + 256 * j); y0p[rr][j] = *(const unsigned*)(y0 + 256 * j); y1p[rr][j] = *(const unsigned*)(y0 + DM + 256 * j); } } } while (0)
    LN2_LOAD(0);
    __syncthreads();
#pragma unroll 1
    for (int grp = 0; grp < rpb / 16; ++grp) {
        const int bpg = row_bp(rblk + grp * 16);
        if (bpg != bp_cur) { bp_cur = bpg; __syncthreads();
            for (int i = F.tid; i < 1024; i += NTHREADS) { vec[2048 + i] = modl[(size_t)bp_cur * 6144 + 5 * 1024 + i]; vec[3072 + i] = modn[(size_t)bp_cur * 6144 + i]; vec[4096 + i] = modn[(size_t)bp_cur * 6144 + 1024 + i]; }
            __syncthreads(); }
        f32x4 z[2][4]; float s[2] = {0.f, 0.f};
#pragma unroll
        for (int rr = 0; rr < 2; ++rr)
#pragma unroll
            for (int j = 0; j < 4; ++j) { const f32x4 gt = *(const LAS f32x4*)(vec + 2048 + F.lane * 4 + 256 * j); const int a = (int)y0p[rr][j], b = (int)y1p[rr][j];
                f32x4 f; f[0] = __builtin_amdgcn_cvt_f32_fp8(a, 0) + __builtin_amdgcn_cvt_f32_fp8(b, 0); f[1] = __builtin_amdgcn_cvt_f32_fp8(a, 1) + __builtin_amdgcn_cvt_f32_fp8(b, 1);
                f[2] = __builtin_amdgcn_cvt_f32_fp8(a, 2) + __builtin_amdgcn_cvt_f32_fp8(b, 2); f[3] = __builtin_amdgcn_cvt_f32_fp8(a, 3) + __builtin_amdgcn_cvt_f32_fp8(b, 3); f *= (1.0f / 64.0f);
                const f32x4 hh = unpack_h4(hpre[rr][j]);
                z[rr][j] = hh * ALPHA + gt * f; s[rr] += (z[rr][j][0] + z[rr][j][1]) + (z[rr][j][2] + z[rr][j][3]); }
        if (grp + 1 < rpb / 16) LN2_LOAD(grp + 1);
#pragma unroll
        for (int m = 32; m >= 1; m >>= 1) { s[0] += __shfl_xor(s[0], m, 64); s[1] += __shfl_xor(s[1], m, 64); }
        float s2[2] = {0.f, 0.f};
#pragma unroll
        for (int rr = 0; rr < 2; ++rr) { const float mean = s[rr] * (1.0f / 1024.0f);
#pragma unroll
            for (int j = 0; j < 4; ++j) { z[rr][j] -= mean; s2[rr] += (z[rr][j][0] * z[rr][j][0] + z[rr][j][1] * z[rr][j][1]) + (z[rr][j][2] * z[rr][j][2] + z[rr][j][3] * z[rr][j][3]); } }
#pragma unroll
        for (int m = 32; m >= 1; m >>= 1) { s2[0] += __shfl_xor(s2[0], m, 64); s2[1] += __shfl_xor(s2[1], m, 64); }
#pragma unroll
        for (int rr = 0; rr < 2; ++rr) {
            const int row = rblk + grp * 16 + F.wave * 2 + rr; const float rstd = rsqrtf(s2[rr] * (1.0f / 1024.0f) + LN_EPS);
#pragma unroll
            for (int j = 0; j < 4; ++j) { const int c = F.lane * 4 + 256 * j;
                const f32x4 h = z[rr][j] * rstd * *(const LAS f32x4*)(vec + c) + *(const LAS f32x4*)(vec + 1024 + c);
                if (!has_next) { *(f32x4*)(F.out() + (size_t)(row - NCTX) * DM + c) = h; }
                else *(u32x2*)(F.H16() + (size_t)row * DM + c) = pack_h4(h);
                if (has_next) { const f32x4 sh = *(const LAS f32x4*)(vec + 3072 + c), sc = *(const LAS f32x4*)(vec + 4096 + c); const f32x4 v = h * (sc + 1.0f) + sh;
                    u32x2 w; w.x = cvt_pk_bf16(v[0], v[1]); w.y = cvt_pk_bf16(v[2], v[3]); *(u32x2*)(F.U() + (size_t)row * DM + c) = w; } }
        }
    }
#undef LN2_LOAD
    __syncthreads();
}

DI void mla_prep_row(const Ctx& F, int row, const u32x4& c0, const u32x4& c1) {
    bf16_t* DQ = (bf16_t*)(F.S() + S_DQ); bf16_t* DKV = (bf16_t*)(F.S() + S_DKV); bf16_t* KK = (bf16_t*)(F.S() + S_KK);
    const float* qn = F.in(13); const float* kn = F.in(14); const int L = F.lane;
    float a[8], b[8];
    a[0] = bflo(c0.x); a[1] = bfhi(c0.x); a[2] = bflo(c0.y); a[3] = bfhi(c0.y); a[4] = bflo(c0.z); a[5] = bfhi(c0.z); a[6] = bflo(c0.w); a[7] = bfhi(c0.w);
    b[0] = bflo(c1.x); b[1] = bfhi(c1.x); b[2] = bflo(c1.y); b[3] = bfhi(c1.y); b[4] = bflo(c1.z); b[5] = bfhi(c1.z); b[6] = bflo(c1.w); b[7] = bfhi(c1.w);
    float sa = 0.f, sb = 0.f;
#pragma unroll
    for (int j = 0; j < 8; ++j) { sa += a[j] * a[j]; sb += b[j] * b[j]; }
    float sq = (L < 48) ? sa : 0.f, sk = ((L >= 48) ? sa : 0.f) + ((L < 16) ? sb : 0.f);
#pragma unroll
    for (int m = 32; m >= 1; m >>= 1) { sq += __shfl_xor(sq, m, 64); sk += __shfl_xor(sk, m, 64); }
    const float rq = rsqrtf(sq * (1.0f / 384.0f) + RMS_EPS), rk = rsqrtf(sk * (1.0f / 256.0f) + RMS_EPS);
    {   const float* gp = (L < 48) ? (qn + 8 * L) : (kn + 8 * (L - 48)); const float r = (L < 48) ? rq : rk;
        const f32x4 g0 = *(const f32x4*)gp, g1 = *(const f32x4*)(gp + 4);
        f32x4 o0, o1; o0[0] = a[0] * r * g0[0]; o0[1] = a[1] * r * g0[1]; o0[2] = a[2] * r * g0[2]; o0[3] = a[3] * r * g0[3]; o1[0] = a[4] * r * g1[0]; o1[1] = a[5] * r * g1[1]; o1[2] = a[6] * r * g1[2]; o1[3] = a[7] * r * g1[3];
        bf16_t* dst = (L < 48) ? (DQ + (size_t)row * 384 + 8 * L) : (DKV + (size_t)row * 256 + 8 * (L - 48));
        *(u32x4*)dst = pack8(o0, o1); }
    if (L < 16) { const float* gp = kn + 8 * (L + 16); const f32x4 g0 = *(const f32x4*)gp, g1 = *(const f32x4*)(gp + 4);
        f32x4 o0, o1; o0[0] = b[0] * rk * g0[0]; o0[1] = b[1] * rk * g0[1]; o0[2] = b[2] * rk * g0[2]; o0[3] = b[3] * rk * g0[3]; o1[0] = b[4] * rk * g1[0]; o1[1] = b[5] * rk * g1[1]; o1[2] = b[6] * rk * g1[2]; o1[3] = b[7] * rk * g1[3];
        *(u32x4*)(DKV + (size_t)row * 256 + 8 * (L + 16)) = pack8(o0, o1); }
    float pr[8];
#pragma unroll
    for (int j = 0; j < 8; ++j) pr[j] = __shfl_xor(b[j], 4, 64);
    if (L >= 16 && L < 24) {
        const int m = L - 16; int bb, pos; f32x4 o0, o1;
        if (row >= NCTX) { const int rr = row - NCTX; bb = rr >> 12; const int t = rr & 4095; pos = CTXL + t;
            const int i0 = (m & 3) * 8;
            const int p = (i0 < 16) ? (t >> 6) : (t & 63); const float* cp = F.MC() + p * 16 + (i0 & 15); const float* sp = F.MS() + p * 16 + (i0 & 15);
            const f32x4 ca = *(const f32x4*)cp, cb = *(const f32x4*)(cp + 4), sa4 = *(const f32x4*)sp, sb4 = *(const f32x4*)(sp + 4);
#pragma unroll
            for (int j = 0; j < 8; ++j) { const float c = j < 4 ? ca[j & 3] : cb[j & 3], s = j < 4 ? sa4[j & 3] : sb4[j & 3];
                const float v = (m < 4) ? (b[j] * c - pr[j] * s) : (pr[j] * s + b[j] * c);
                if (j < 4) o0[j & 3] = v; else o1[j & 3] = v; }
        } else { bb = row >> 8; pos = row & 255;
#pragma unroll
            for (int j = 0; j < 8; ++j) { if (j < 4) o0[j & 3] = b[j]; else o1[j & 3] = b[j]; } }
        const u32x4 w = pack8(o0, o1);
#pragma unroll
        for (int h = 0; h < 8; ++h) *(u32x4*)(KK + ((size_t)(bb * 8 + h) * KVLEN + pos) * 192 + 128 + 8 * m) = w;
    }
}
DI void phase_mla_prep(const Ctx& F) {
    const bf16_t* DWN = (const bf16_t*)(F.S() + S_DWN);
    const int L = F.lane, L2 = (L < 24) ? (64 + L) : L;
#define PREP_LOAD(A0, A1, B0, B1, r_) do { const int r1_ = (r_) < NTOK ? (r_) : 0, r2_ = (r_) + F.G * 8 < NTOK ? (r_) + F.G * 8 : r1_; \
        A0 = *(const u32x4*)(DWN + (size_t)r1_ * 768 + 8 * L); A1 = *(const u32x4*)(DWN + (size_t)r1_ * 768 + 8 * L2); \
        B0 = *(const u32x4*)(DWN + (size_t)r2_ * 768 + 8 * L); B1 = *(const u32x4*)(DWN + (size_t)r2_ * 768 + 8 * L2); } while (0)
#define PREP_PROC(A0, A1, B0, B1, r_) do { if ((r_) < NTOK) { mla_prep_row(F, (r_), A0, A1); if ((r_) + F.G * 8 < NTOK) mla_prep_row(F, (r_) + F.G * 8, B0, B1); } } while (0)
    const int step = F.G * 16;
    int row = F.bid * 8 + F.wave;
    u32x4 xa0, xa1, xb0, xb1, ya0, ya1, yb0, yb1;
    PREP_LOAD(xa0, xa1, xb0, xb1, row);
    for (; row < NTOK; row += 2 * step) {
        PREP_LOAD(ya0, ya1, yb0, yb1, row + step);
        PREP_PROC(xa0, xa1, xb0, xb1, row);
        PREP_LOAD(xa0, xa1, xb0, xb1, row + 2 * step);
        PREP_PROC(ya0, ya1, yb0, yb1, row + step);
    }
#undef PREP_LOAD
#undef PREP_PROC
}

DI void phase_stats_fin(const Ctx& F) {
    const float* ST = (const float*)(F.ws + WS_STATS); float* MR = (float*)(F.ws + WS_MR);
    for (int i = F.bid * NTHREADS + F.tid; i < NTOK * 4; i += F.G * NTHREADS) {
        const f32x4 a0 = *(const f32x4*)(ST + (size_t)i * 16), a1 = *(const f32x4*)(ST + (size_t)i * 16 + 4), a2 = *(const f32x4*)(ST + (size_t)i * 16 + 8), a3 = *(const f32x4*)(ST + (size_t)i * 16 + 12);
        const float s = (a0[0] + a0[2]) + (a1[0] + a1[2]) + (a2[0] + a2[2]) + (a3[0] + a3[2]);
        const float ss = (a0[1] + a0[3]) + (a1[1] + a1[3]) + (a2[1] + a2[3]) + (a3[1] + a3[3]);
        const float mean = s * (1.0f / 512.0f); float var = ss * (1.0f / 512.0f) - mean * mean; var = var > 0.f ? var : 0.f;
        *(f32x2*)(MR + (size_t)i * 2) = (f32x2){mean, rsqrtf(var + LN_EPS)};
    }
}

DI void conv8(f32x4& ra, f32x4& rb, const u32x4& pm, const u32x4& pc, const u32x4& pp, const u32x4& gb, const f32x4 (&w)[6], const f32x4& ba, const f32x4& bb) {
    ra[0] = bflo(gb.x) * (bflo(pm.x) * w[0][0] + bflo(pc.x) * w[2][0] + bflo(pp.x) * w[4][0] + ba[0]);
    ra[1] = bfhi(gb.x) * (bfhi(pm.x) * w[0][1] + bfhi(pc.x) * w[2][1] + bfhi(pp.x) * w[4][1] + ba[1]);
    ra[2] = bflo(gb.y) * (bflo(pm.y) * w[0][2] + bflo(pc.y) * w[2][2] + bflo(pp.y) * w[4][2] + ba[2]);
    ra[3] = bfhi(gb.y) * (bfhi(pm.y) * w[0][3] + bfhi(pc.y) * w[2][3] + bfhi(pp.y) * w[4][3] + ba[3]);
    rb[0] = bflo(gb.z) * (bflo(pm.z) * w[1][0] + bflo(pc.z) * w[3][0] + bflo(pp.z) * w[5][0] + bb[0]);
    rb[1] = bfhi(gb.z) * (bfhi(pm.z) * w[1][1] + bfhi(pc.z) * w[3][1] + bfhi(pp.z) * w[5][1] + bb[1]);
    rb[2] = bflo(gb.w) * (bflo(pm.w) * w[1][2] + bflo(pc.w) * w[3][2] + bflo(pp.w) * w[5][2] + bb[2]);
    rb[3] = bfhi(gb.w) * (bfhi(pm.w) * w[1][3] + bfhi(pc.w) * w[3][3] + bfhi(pp.w) * w[5][3] + bb[3]);
}
DI void phase_conv(const Ctx& F) {
    const bf16_t* PB = (const bf16_t*)(F.S() + S_PB); const bf16_t* GB = (const bf16_t*)(F.S() + S_GB); bf16_t* A2 = (bf16_t*)(F.S() + S_A2);
    const float* cw = F.in(19); const float* cb = F.in(20);
    const int c0 = (F.tid & 127) * 8;
    f32x4 w[6];
#pragma unroll
    for (int k = 0; k < 3; ++k) { w[2 * k] = *(const f32x4*)(cw + k * 1024 + c0); w[2 * k + 1] = *(const f32x4*)(cw + k * 1024 + c0 + 4); }
    const f32x4 ba = *(const f32x4*)(cb + c0), bb = *(const f32x4*)(cb + c0 + 4);
    const u32x4 zero = {0u, 0u, 0u, 0u};
    for (int run = F.bid * 4 + (F.tid >> 7); run < NTOK / 8; run += F.G * 4) {
        const int r0 = run * 8; const int t0 = r0 < NCTX ? (r0 & 255) : ((r0 - NCTX) & 4095); const int tl = r0 < NCTX ? 256 : 4096;
        u32x4 p[10], gb[8];
        p[0] = (t0 > 0) ? *(const u32x4*)(PB + (size_t)(r0 - 1) * DM + c0) : zero;
#pragma unroll
        for (int i = 0; i < 8; ++i) { p[i + 1] = *(const u32x4*)(PB + (size_t)(r0 + i) * DM + c0); gb[i] = *(const u32x4*)(GB + (size_t)(r0 + i) * DM + c0); }
        p[9] = (t0 + 8 < tl) ? *(const u32x4*)(PB + (size_t)(r0 + 8) * DM + c0) : zero;
#pragma unroll
        for (int i = 0; i < 8; ++i) { f32x4 ra, rb; conv8(ra, rb, p[i], p[i + 1], p[i + 2], gb[i], w, ba, bb); *(u32x4*)(A2 + (size_t)(r0 + i) * DM + c0) = pack8(ra, rb); }
    }
}
constexpr int SC_Q = 0, SC_K = 32768, SC_V = 65536, SC_S = 81920, SC_P = 147456, SC_FLAG = SC_P + 64 * 144, SC_END = SC_FLAG + 64;
static_assert(SC_END <= XB_LDS_OFF, "scan LDS");
DI unsigned off_a(unsigned row, unsigned ch) { return 2048u * (row >> 3) + 512u * (ch >> 2) + 64u * (row & 7) + 16u * ((ch & 3) ^ ((0u - (row >> 2)) & 3)); }
#define MFMA16(a, b, c) __builtin_amdgcn_mfma_f32_16x16x32_bf16((a), (b), (c), 0, 0, 0)
DI void tr_read8(s16x4 (&r)[8], unsigned a0, unsigned a1, unsigned a2, unsigned a3, unsigned a4, unsigned a5, unsigned a6, unsigned a7) {
    asm volatile("ds_read_b64_tr_b16 %0, %8\n\tds_read_b64_tr_b16 %1, %9\n\tds_read_b64_tr_b16 %2, %10\n\tds_read_b64_tr_b16 %3, %11\n\t"
                 "ds_read_b64_tr_b16 %4, %12\n\tds_read_b64_tr_b16 %5, %13\n\tds_read_b64_tr_b16 %6, %14\n\tds_read_b64_tr_b16 %7, %15\n\ts_waitcnt lgkmcnt(0)"
                 : "=&v"(r[0]), "=&v"(r[1]), "=&v"(r[2]), "=&v"(r[3]), "=&v"(r[4]), "=&v"(r[5]), "=&v"(r[6]), "=&v"(r[7])
                 : "v"(a0), "v"(a1), "v"(a2), "v"(a3), "v"(a4), "v"(a5), "v"(a6), "v"(a7) : "memory");
}
DI void tr_read4(s16x4 (&r)[4], unsigned a0, unsigned a1, unsigned a2, unsigned a3) {
    asm volatile("ds_read_b64_tr_b16 %0, %4\n\tds_read_b64_tr_b16 %1, %5\n\tds_read_b64_tr_b16 %2, %6\n\tds_read_b64_tr_b16 %3, %7\n\ts_waitcnt lgkmcnt(0)"
                 : "=&v"(r[0]), "=&v"(r[1]), "=&v"(r[2]), "=&v"(r[3]) : "v"(a0), "v"(a1), "v"(a2), "v"(a3) : "memory");
}
template <int OFF> DI void tr_read8i(s16x4 (&r)[8], unsigned b00, unsigned b10, unsigned b01, unsigned b11) {
    asm volatile("ds_read_b64_tr_b16 %0, %8 offset:%12\n\tds_read_b64_tr_b16 %1, %9 offset:%12\n\tds_read_b64_tr_b16 %2, %10 offset:%12\n\tds_read_b64_tr_b16 %3, %11 offset:%12\n\t"
                 "ds_read_b64_tr_b16 %4, %8 offset:%13\n\tds_read_b64_tr_b16 %5, %9 offset:%13\n\tds_read_b64_tr_b16 %6, %10 offset:%13\n\tds_read_b64_tr_b16 %7, %11 offset:%13\n\ts_waitcnt lgkmcnt(0)"
                 : "=&v"(r[0]), "=&v"(r[1]), "=&v"(r[2]), "=&v"(r[3]), "=&v"(r[4]), "=&v"(r[5]), "=&v"(r[6]), "=&v"(r[7])
                 : "v"(b00), "v"(b10), "v"(b01), "v"(b11), "i"(OFF), "i"(OFF + 512) : "memory");
}
template <int OFF> DI void tr_read4i(s16x4 (&r)[4], unsigned b00, unsigned b10, unsigned b01, unsigned b11) {
    asm volatile("ds_read_b64_tr_b16 %0, %4 offset:%8\n\tds_read_b64_tr_b16 %1, %5 offset:%8\n\tds_read_b64_tr_b16 %2, %6 offset:%8\n\tds_read_b64_tr_b16 %3, %7 offset:%8\n\ts_waitcnt lgkmcnt(0)"
                 : "=&v"(r[0]), "=&v"(r[1]), "=&v"(r[2]), "=&v"(r[3]) : "v"(b00), "v"(b10), "v"(b01), "v"(b11), "i"(OFF) : "memory");
}
#define TR_OUT8(r) "=&v"(r[0]), "=&v"(r[1]), "=&v"(r[2]), "=&v"(r[3]), "=&v"(r[4]), "=&v"(r[5]), "=&v"(r[6]), "=&v"(r[7])
#define TR_IO8(r) "+v"(r[0]), "+v"(r[1]), "+v"(r[2]), "+v"(r[3]), "+v"(r[4]), "+v"(r[5]), "+v"(r[6]), "+v"(r[7])
template <int OFF> DI void tr_issue8(s16x4 (&rn)[8], unsigned b00, unsigned b10, unsigned b01, unsigned b11) {
    asm volatile("ds_read_b64_tr_b16 %0, %8 offset:%12\n\tds_read_b64_tr_b16 %1, %9 offset:%12\n\tds_read_b64_tr_b16 %2, %10 offset:%12\n\tds_read_b64_tr_b16 %3, %11 offset:%12\n\t"
                 "ds_read_b64_tr_b16 %4, %8 offset:%13\n\tds_read_b64_tr_b16 %5, %9 offset:%13\n\tds_read_b64_tr_b16 %6, %10 offset:%13\n\tds_read_b64_tr_b16 %7, %11 offset:%13"
                 : TR_OUT8(rn) : "v"(b00), "v"(b10), "v"(b01), "v"(b11), "i"(OFF), "i"(OFF + 512) : "memory");
}
template <int OFF> DI void tr_issue8_wait8(s16x4 (&rn)[8], s16x4 (&ro)[8], unsigned b00, unsigned b10, unsigned b01, unsigned b11) {
    asm volatile("ds_read_b64_tr_b16 %0, %16 offset:%20\n\tds_read_b64_tr_b16 %1, %17 offset:%20\n\tds_read_b64_tr_b16 %2, %18 offset:%20\n\tds_read_b64_tr_b16 %3, %19 offset:%20\n\t"
                 "ds_read_b64_tr_b16 %4, %16 offset:%21\n\tds_read_b64_tr_b16 %5, %17 offset:%21\n\tds_read_b64_tr_b16 %6, %18 offset:%21\n\tds_read_b64_tr_b16 %7, %19 offset:%21\n\ts_waitcnt lgkmcnt(8)"
                 : TR_OUT8(rn), TR_IO8(ro) : "v"(b00), "v"(b10), "v"(b01), "v"(b11), "i"(OFF), "i"(OFF + 512) : "memory");
}
DI void tr_wait0(s16x4 (&ro)[8]) { asm volatile("s_waitcnt lgkmcnt(0)" : TR_IO8(ro) :: "memory"); }
DI bf16x8 cat4(const s16x4& lo, const s16x4& hi) { return __builtin_shufflevector(lo, hi, 0, 1, 2, 3, 4, 5, 6, 7); }
DI int scan_chunk_row(int b, int dir, int step) {
    if (dir == 0) return step < 4 ? b * 256 + step * 64 : NCTX + b * 4096 + (step - 4) * 64;
    return step < 4 ? b * 256 + (3 - step) * 64 : NCTX + b * 4096 + (67 - step) * 64;
}
DI void phase_ret_scan(const Ctx& F, int jl) {
    const bf16_t* QKV = (const bf16_t*)(F.S() + S_QKV); bf16_t* Obuf = (bf16_t*)(F.S() + S_O); float* STATS = (float*)(F.ws + WS_STATS);
    const float* decay = F.in(9) + jl * 8;
    LAS unsigned char* lds = F.lds; const unsigned ldsb = (unsigned)(uintptr_t)lds;
    const int w = F.wave, it = w >> 1, wh = w & 1;
    unsigned pseq = 0u;
    if (F.tid < 8) *(LAS unsigned*)(lds + SC_FLAG + 4 * F.tid) = 0u;
    for (int item = F.bid; item < 256; item += F.G) {
        const int bhx = ((item & 7) << 3) | (item >> 5), b = bhx >> 2, h = bhx & 3, sl = (item >> 3) & 3;
        for (int dir = 0; dir < 2; ++dir) {
            const float x = decay[dir * 4 + h]; const float lg2 = -log1pf(expf(-x)) * 1.4426950408889634f;
            const float gL = exp2f(lg2 * 64.0f);
            f32x4 st[2][8];
#pragma unroll
            for (int dd = 0; dd < 2; ++dd)
#pragma unroll
                for (int et = 0; et < 8; ++et) st[dd][et] = (f32x4){0.f, 0.f, 0.f, 0.f};
            u32x4 qreg[4], kreg[4], vreg[2];
            {   const int rb = scan_chunk_row(b, dir, 0);
                const int srow = 8 * (F.tid >> 6) + ((F.tid >> 2) & 7), sub = (F.tid >> 5) & 1, c4 = F.tid & 3;
#pragma unroll
                for (int i = 0; i < 4; ++i) { const bf16_t* src = QKV + (size_t)(rb + srow) * 4096 + h * 256 + (4 * (sub + 2 * i) + c4) * 8; qreg[i] = *(const u32x4*)src; kreg[i] = *(const u32x4*)(src + 1024); }
#pragma unroll
                for (int i = 0; i < 2; ++i) vreg[i] = *(const u32x4*)(QKV + (size_t)(rb + srow) * 4096 + 2048 + h * 512 + sl * 128 + (4 * (sub + 2 * i) + c4) * 8);
            }
            for (int step = 0; step < 68; ++step) {
                const int rb = scan_chunk_row(b, dir, step);
                int tz = F.tid; asm volatile("" : "+v"(tz));
                const int lane = tz & 63, g = lane >> 4, l15 = lane & 15, qd = l15 >> 2, pp = lane & 3, ph = pp >> 1;
                const int srow = 8 * (tz >> 6) + ((tz >> 2) & 7), sub = (tz >> 5) & 1, c4 = tz & 3;
                const unsigned rowbase = off_a(l15, g);
                unsigned trb[2][2];
#pragma unroll
                for (int t = 0; t < 2; ++t)
#pragma unroll
                    for (int par = 0; par < 2; ++par) trb[t][par] = ldsb + off_a(8 * g + 4 * t + qd, 2 * par + ph) + 8 * (pp & 1);
                const unsigned sdb0 = SC_S + 2048u * ((16 * 2 * w + l15) >> 3) + 64u * (l15 & 7) + 16u * ((g >> 1) ^ (qd & 1)) + 8u * ((g & 1) ^ ((l15 >> 1) & 1));
                const unsigned sdh = ((qd >> 1) ^ qd) & 1; const unsigned sdbp[2] = {sdb0 + 32u * sdh, sdb0 + 32u * (1 - sdh)};
#pragma unroll
                for (int dd = 0; dd < 2; ++dd)
#pragma unroll
                    for (int et = 0; et < 8; ++et) { st[dd][et] *= gL;
                        u32x2 pk; pk.x = cvt_pk_bf16(st[dd][et][0], st[dd][et][1]); pk.y = cvt_pk_bf16(st[dd][et][2], st[dd][et][3]);
                        *(LAS u32x2*)(lds + sdbp[et & 1] + 4096u * dd + 512u * (et >> 1)) = pk; }
                const float vs = exp2f(lg2 * (float)(dir == 0 ? 63 - srow : srow));
#pragma unroll
                for (int i = 0; i < 4; ++i) { const int cb = sub + 2 * i; const unsigned o = (cb >> 2) * 16384 + off_a(srow, 4 * (cb & 3) + c4); *(LAS u32x4*)(lds + SC_Q + o) = qreg[i]; *(LAS u32x4*)(lds + SC_K + o) = kreg[i]; }
#pragma unroll
                for (int i = 0; i < 2; ++i) { const u32x4 v = vreg[i]; u32x4 ks;
                    ks.x = cvt_pk_bf16(bflo(v.x) * vs, bfhi(v.x) * vs); ks.y = cvt_pk_bf16(bflo(v.y) * vs, bfhi(v.y) * vs); ks.z = cvt_pk_bf16(bflo(v.z) * vs, bfhi(v.z) * vs); ks.w = cvt_pk_bf16(bflo(v.w) * vs, bfhi(v.w) * vs);
                    *(LAS u32x4*)(lds + SC_V + off_a(srow, 4 * (sub + 2 * i) + c4)) = ks; }
                __syncthreads();
                if (step + 1 < 68) { const int rn = scan_chunk_row(b, dir, step + 1);
#pragma unroll
                    for (int i = 0; i < 4; ++i) { const bf16_t* src = QKV + (size_t)(rn + srow) * 4096 + h * 256 + (4 * (sub + 2 * i) + c4) * 8; qreg[i] = *(const u32x4*)src; kreg[i] = *(const u32x4*)(src + 1024); }
#pragma unroll
                    for (int i = 0; i < 2; ++i) vreg[i] = *(const u32x4*)(QKV + (size_t)(rn + srow) * 4096 + 2048 + h * 512 + sl * 128 + (4 * (sub + 2 * i) + c4) * 8);
                }
                bf16_t* const op = Obuf + (size_t)(rb + 16 * it + l15) * 2048 + h * 512 + sl * 128 + 64 * wh + 4 * g;
                u32x2 ofw[4];
                if (dir == 1) {
#pragma unroll
                    for (int e4 = 0; e4 < 4; ++e4) ofw[e4] = *(const u32x2*)(op + 16 * e4);
                }
                bf16x8 qf[8]; f32x4 pacc[2]; pacc[0] = (f32x4){0.f, 0.f, 0.f, 0.f}; pacc[1] = pacc[0];
#pragma unroll
                for (int s8 = 0; s8 < 8; ++s8) { const unsigned io = (s8 >> 2) * 16384 + rowbase + 512 * (s8 & 3);
                    qf[s8] = *(const LAS bf16x8*)(lds + SC_Q + io + 4096 * it);
#pragma unroll
                    for (int jj = 0; jj < 2; ++jj) { const bf16x8 kf = *(const LAS bf16x8*)(lds + SC_K + io + 4096 * (2 * wh + jj)); pacc[jj] = MFMA16(kf, qf[s8], pacc[jj]); } }
#pragma unroll
                for (int jj = 0; jj < 2; ++jj) { const int i = 16 * it + l15, j0 = 16 * (2 * wh + jj) + 4 * g; f32x4 pv = pacc[jj];
#pragma unroll
                    for (int r = 0; r < 4; ++r) { const bool keep = (dir == 0) ? (j0 + r <= i) : (j0 + r >= i); pv[r] = keep ? pv[r] : 0.f; }
                    u32x2 pk; pk.x = cvt_pk_bf16(pv[0], pv[1]); pk.y = cvt_pk_bf16(pv[2], pv[3]); *(LAS u32x2*)(lds + SC_P + i * 144 + j0 * 2) = pk; }
                {   ++pseq; asm volatile("" ::: "memory");
                    if (lane == 0) *(volatile LAS unsigned*)(lds + SC_FLAG + 4 * w) = pseq;
                    while ((int)(*(volatile LAS unsigned*)(lds + SC_FLAG + 4 * (w ^ 1)) - pseq) < 0) __builtin_amdgcn_s_sleep(1);
                    asm volatile("" ::: "memory"); }
                f32x4 oacc[4];
#pragma unroll
                for (int e4 = 0; e4 < 4; ++e4) oacc[e4] = (f32x4){0.f, 0.f, 0.f, 0.f};
                {   const unsigned wo = SC_S + 1024u * wh + (((qd >> 1) & 1) ? 8u - 16u * (pp & 1) : 0u);
                    const unsigned s00 = trb[0][0] + wo, s10 = trb[1][0] + wo, s01 = trb[0][1] + wo, s11 = trb[1][1] + wo;
                    const unsigned wv = SC_V + 1024u * wh; const unsigned v00 = trb[0][0] + wv, v10 = trb[1][0] + wv, v01 = trb[0][1] + wv, v11 = trb[1][1] + wv;
                    const unsigned pb = SC_P + (16 * it + l15) * 144 + 16 * g;
                    const bf16x8 pf0 = *(const LAS bf16x8*)(lds + pb), pf1 = *(const LAS bf16x8*)(lds + pb + 64);
                    asm volatile("s_waitcnt lgkmcnt(0)" ::: "memory");
                    s16x4 ra[8], rb[8];
#define O_MMA(R, BF) { _Pragma("unroll") for (int e4 = 0; e4 < 4; ++e4) oacc[e4] = MFMA16(cat4(R[2 * e4], R[2 * e4 + 1]), BF, oacc[e4]); }
                    tr_issue8<0>(ra, s00, s10, s01, s11);
                    tr_issue8_wait8<8192 * 1>(rb, ra, s00, s10, s01, s11); O_MMA(ra, qf[0])
                    tr_issue8_wait8<8192 * 2>(ra, rb, s00, s10, s01, s11); O_MMA(rb, qf[1])
                    tr_issue8_wait8<8192 * 3>(rb, ra, s00, s10, s01, s11); O_MMA(ra, qf[2])
                    tr_issue8_wait8<8192 * 4>(ra, rb, s00, s10, s01, s11); O_MMA(rb, qf[3])
                    tr_issue8_wait8<8192 * 5>(rb, ra, s00, s10, s01, s11); O_MMA(ra, qf[4])
                    tr_issue8_wait8<8192 * 6>(ra, rb, s00, s10, s01, s11); O_MMA(rb, qf[5])
                    tr_issue8_wait8<8192 * 7>(rb, ra, s00, s10, s01, s11); O_MMA(ra, qf[6])
                    tr_issue8_wait8<0>(ra, rb, v00, v10, v01, v11);        O_MMA(rb, qf[7])
                    tr_issue8_wait8<8192>(rb, ra, v00, v10, v01, v11);     O_MMA(ra, pf0)
                    tr_wait0(rb);                                           O_MMA(rb, pf1)
#undef O_MMA
                }
                {   const int i = 16 * it + l15; const float rs = exp2f(lg2 * (float)(dir == 0 ? i - 63 : -i)); float s1 = 0.f, s2 = 0.f;
#pragma unroll
                    for (int e4 = 0; e4 < 4; ++e4) { f32x4 v = oacc[e4] * rs;
                        if (dir == 1) { v[0] += bflo(ofw[e4].x); v[1] += bfhi(ofw[e4].x); v[2] += bflo(ofw[e4].y); v[3] += bfhi(ofw[e4].y); }
                        u32x2 pk; pk.x = cvt_pk_bf16(v[0], v[1]); pk.y = cvt_pk_bf16(v[2], v[3]); *(u32x2*)(op + 16 * e4) = pk;
                        const float a0 = bflo(pk.x), a1 = bfhi(pk.x), a2 = bflo(pk.y), a3 = bfhi(pk.y); s1 += (a0 + a1) + (a2 + a3); s2 += (a0 * a0 + a1 * a1) + (a2 * a2 + a3 * a3); }
                    if (dir == 1) {
                        s1 += __shfl_xor(s1, 16, 64); s2 += __shfl_xor(s2, 16, 64); s1 += __shfl_xor(s1, 32, 64); s2 += __shfl_xor(s2, 32, 64);
                        if (g == 0) { float* sp = STATS + ((size_t)(rb + i) * 4 + h) * 16 + (sl * 2 + wh) * 2; *(f32x2*)sp = (f32x2){s1, s2}; }
                    }
                }
                {   const unsigned ko = SC_K + (w >> 2) * 16384 + 512u * (w & 3); const unsigned k00 = trb[0][0] + ko, k10 = trb[1][0] + ko, k01 = trb[0][1] + ko, k11 = trb[1][1] + ko;
                    const unsigned v00 = trb[0][0] + SC_V, v10 = trb[1][0] + SC_V, v01 = trb[0][1] + SC_V, v11 = trb[1][1] + SC_V;
                    s16x4 kr[8], ra[8], rb[8];
                    asm volatile("ds_read_b64_tr_b16 %0, %8\n\tds_read_b64_tr_b16 %1, %9\n\tds_read_b64_tr_b16 %2, %10\n\tds_read_b64_tr_b16 %3, %11\n\t"
                                 "ds_read_b64_tr_b16 %4, %8 offset:8192\n\tds_read_b64_tr_b16 %5, %9 offset:8192\n\tds_read_b64_tr_b16 %6, %10 offset:8192\n\tds_read_b64_tr_b16 %7, %11 offset:8192"
                                 : TR_OUT8(kr) : "v"(k00), "v"(k10), "v"(k01), "v"(k11) : "memory");
                    tr_issue8_wait8<0>(ra, kr, v00, v10, v01, v11);
                    const bf16x8 kf00 = cat4(kr[0], kr[1]), kf01 = cat4(kr[2], kr[3]), kf10 = cat4(kr[4], kr[5]), kf11 = cat4(kr[6], kr[7]);
#define S_MMA(R, EB, KA, KB) { _Pragma("unroll") for (int e4 = 0; e4 < 4; ++e4) { const bf16x8 vf = cat4(R[2 * e4], R[2 * e4 + 1]); \
                        st[0][4 * (EB) + e4] = MFMA16(vf, KA, st[0][4 * (EB) + e4]); st[1][4 * (EB) + e4] = MFMA16(vf, KB, st[1][4 * (EB) + e4]); } }
                    tr_issue8_wait8<1024>(rb, ra, v00, v10, v01, v11);          S_MMA(ra, 0, kf00, kf01)
                    tr_issue8_wait8<8192>(ra, rb, v00, v10, v01, v11);          S_MMA(rb, 1, kf00, kf01)
                    tr_issue8_wait8<8192 + 1024>(rb, ra, v00, v10, v01, v11);   S_MMA(ra, 0, kf10, kf11)
                    tr_wait0(rb);                                                S_MMA(rb, 1, kf10, kf11)
#undef S_MMA
                }
                __syncthreads();
            }
        }
    }
}
namespace att {
constexpr int DQK = 192, DV = 128, NW = 8, QBLK = 32, KVBLK = 64;
constexpr float SCALE = 0.07216878364870322f;
constexpr float THR = 8.f;
constexpr int LDQ = 1536, LDK = 192, LDV = 128, LDO = 1024;
constexpr int KROWB = 400;
constexpr int SHM_V = KVBLK * DV * 2, SHM_K = KVBLK * KROWB, SHM_ATTN = 2 * SHM_V + 2 * SHM_K + NW * 64 * 4;
#define KSWZ(row, colB) ((row) * KROWB + (colB))
#define SBAR() __builtin_amdgcn_sched_barrier(0)
DI int crow(int r, int hi) { return (r & 3) + 8 * (r >> 2) + 4 * hi; }
DI unsigned cvtpk(float lo, float hi) { unsigned r; asm volatile("v_cvt_pk_bf16_f32 %0, %1, %2" : "=v"(r) : "v"(lo), "v"(hi)); return r; }
DI void partialSM(f32x16& p0, f32x16& p1, float& m_reg, float& alpha, f32x16& minit, bool first) {
  constexpr float THRL = THR * 1.4426950408889634f;
  float pmax = p0[0];
#pragma unroll
  for (int r = 1; r < 16; ++r) pmax = fmaxf(pmax, p0[r]);
#pragma unroll
  for (int r = 0; r < 16; ++r) pmax = fmaxf(pmax, p1[r]);
  { auto rr = __builtin_amdgcn_permlane32_swap(__float_as_uint(pmax), __float_as_uint(pmax), false, false);
    pmax = fmaxf(__uint_as_float(rr[0]), __uint_as_float(rr[1])); }
  if (__builtin_expect(!first && __all(pmax <= THRL), 1)) { alpha = 1.f; }
  else { const float d = first ? pmax : fmaxf(pmax, 0.f);
    alpha = first ? 1.f : __builtin_amdgcn_exp2f(-d); m_reg += d;
#pragma unroll
    for (int r = 0; r < 16; ++r) { p0[r] -= d; p1[r] -= d; minit[r] = -m_reg; } }
#pragma unroll
  for (int r = 0; r < 16; ++r) p0[r] = __builtin_amdgcn_exp2f(p0[r]);
}
DI void finishSM(f32x16& p0, f32x16& p1, float alpha, float& l_reg, bf16x8& pa0, bf16x8& pa1, bf16x8& pa2, bf16x8& pa3) {
#pragma unroll
  for (int r = 0; r < 16; ++r) p1[r] = __builtin_amdgcn_exp2f(p1[r]);
  float ps = 0;
#pragma unroll
  for (int r = 0; r < 16; ++r) ps += p0[r];
#pragma unroll
  for (int r = 0; r < 16; ++r) ps += p1[r];
  { auto rr = __builtin_amdgcn_permlane32_swap(__float_as_uint(ps), __float_as_uint(ps), false, false);
    ps = __uint_as_float(rr[0]) + __uint_as_float(rr[1]); }
  l_reg = l_reg * alpha + ps;
#define PK4(P, BASE, OUT) do { unsigned a0 = cvtpk(P[BASE + 0], P[BASE + 1]), a1 = cvtpk(P[BASE + 2], P[BASE + 3]);   \
    unsigned b0 = cvtpk(P[BASE + 4], P[BASE + 5]), b1 = cvtpk(P[BASE + 6], P[BASE + 7]);                              \
    auto r0 = __builtin_amdgcn_permlane32_swap(a0, b0, false, false); auto r1 = __builtin_amdgcn_permlane32_swap(a1, b1, false, false); \
    u32x4 w = {r0[0], r1[0], r0[1], r1[1]}; OUT = *reinterpret_cast<bf16x8*>(&w); } while (0)
  PK4(p0, 0, pa0); PK4(p0, 8, pa1); PK4(p1, 0, pa2); PK4(p1, 8, pa3);
#undef PK4
}
DI void qkt(f32x16& p0, f32x16& p1, const LAS char* Ks, const bf16x8 (&qr)[12], int r32, int hi, const f32x16& minit) {
  p0 = minit; p1 = minit;
#pragma unroll
  for (int d0 = 0; d0 < 12; ++d0) { const int cb = (d0 * 16 + hi * 8) * 2;
    const bf16x8 b0 = *reinterpret_cast<const LAS bf16x8*>(Ks + KSWZ(r32, cb));
    const bf16x8 b1 = *reinterpret_cast<const LAS bf16x8*>(Ks + KSWZ(32 + r32, cb));
    p0 = __builtin_amdgcn_mfma_f32_32x32x16_bf16(b0, qr[d0], p0, 0, 0, 0);
    p1 = __builtin_amdgcn_mfma_f32_32x32x16_bf16(b1, qr[d0], p1, 0, 0, 0); }
}
DI int v_st(int k, int c) { const int kk = (k & ~0xC) | ((k & 4) << 1) | ((k & 8) >> 1); return ((kk >> 3) * 4 + (c >> 5)) * 512 + ((kk & 7) * 32 + (c & 31)) * 2; }
DI int v_rd_base(int lane) { return ((lane & 3) << 3) | (((lane >> 2) & 3) << 6) | (((lane >> 4) & 1) << 5) | (((lane >> 5) & 1) << 8); }
constexpr int v_rd_off(int d0, int ks, int half) { return d0 * 512 + ks * 4096 + half * 2048; }
template <int OFF> DI s16x4 tr_read(int vb) { s16x4 r; asm volatile("ds_read_b64_tr_b16 %0, %1 offset:%2" : "=&v"(r) : "v"(vb), "i"(OFF) : "memory"); return r; }
template <int D0> DI void pv_one(f32x16& od, int vb, bf16x8 pa0, bf16x8 pa1, bf16x8 pa2, bf16x8 pa3) {
  const s16x4 l0 = tr_read<v_rd_off(D0, 0, 0)>(vb), h0 = tr_read<v_rd_off(D0, 0, 1)>(vb), l1 = tr_read<v_rd_off(D0, 1, 0)>(vb), h1 = tr_read<v_rd_off(D0, 1, 1)>(vb);
  const s16x4 l2 = tr_read<v_rd_off(D0, 2, 0)>(vb), h2 = tr_read<v_rd_off(D0, 2, 1)>(vb), l3 = tr_read<v_rd_off(D0, 3, 0)>(vb), h3 = tr_read<v_rd_off(D0, 3, 1)>(vb);
  asm volatile("s_waitcnt lgkmcnt(0)" ::: "memory"); SBAR();
#define PK(L, H) (bf16x8){L[0], L[1], L[2], L[3], H[0], H[1], H[2], H[3]}
  od = __builtin_amdgcn_mfma_f32_32x32x16_bf16(pa0, PK(l0, h0), od, 0, 0, 0);
  od = __builtin_amdgcn_mfma_f32_32x32x16_bf16(pa1, PK(l1, h1), od, 0, 0, 0);
  od = __builtin_amdgcn_mfma_f32_32x32x16_bf16(pa2, PK(l2, h2), od, 0, 0, 0);
  od = __builtin_amdgcn_mfma_f32_32x32x16_bf16(pa3, PK(l3, h3), od, 0, 0, 0);
#undef PK
}
DI void pv_d0(f32x16 (&o)[4], int vb, bf16x8 pa0, bf16x8 pa1, bf16x8 pa2, bf16x8 pa3) {
  pv_one<0>(o[0], vb, pa0, pa1, pa2, pa3); pv_one<1>(o[1], vb, pa0, pa1, pa2, pa3); pv_one<2>(o[2], vb, pa0, pa1, pa2, pa3); pv_one<3>(o[3], vb, pa0, pa1, pa2, pa3);
}
DI void rope8(bf16x8& a, bf16x8& b, const f32x4& c0, const f32x4& c1, const f32x4& s0, const f32x4& s1) {
  float x1[8], x2[8];
#pragma unroll
  for (int e = 0; e < 8; ++e) { x1[e] = bf2f((unsigned short)a[e]); x2[e] = bf2f((unsigned short)b[e]); }
  float o1[8], o2[8];
#pragma unroll
  for (int e = 0; e < 8; ++e) { const float c = e < 4 ? c0[e & 3] : c1[e & 3], s = e < 4 ? s0[e & 3] : s1[e & 3]; o1[e] = x1[e] * c - x2[e] * s; o2[e] = x1[e] * s + x2[e] * c; }
  u32x4 wa = {cvtpk(o1[0], o1[1]), cvtpk(o1[2], o1[3]), cvtpk(o1[4], o1[5]), cvtpk(o1[6], o1[7])}, wb = {cvtpk(o2[0], o2[1]), cvtpk(o2[2], o2[3]), cvtpk(o2[4], o2[5]), cvtpk(o2[6], o2[7])};
  a = *reinterpret_cast<bf16x8*>(&wa); b = *reinterpret_cast<bf16x8*>(&wb);
}
DI void attn_body(const bf16_t* __restrict__ Qb, const bf16_t* __restrict__ Kh, const bf16_t* __restrict__ Vh, bf16_t* __restrict__ Ob, int seq, int t0,
                  const float* __restrict__ MC, const float* __restrict__ MS, LAS char* lds, int wave_id) {
  int tid_l = lane_id_fresh(); asm volatile("" : "+v"(tid_l)); tid_l += 64 * wave_id;
  const int tid = tid_l, wid = tid >> 6, lane = tid & 63, r32 = lane & 31, hi = lane >> 5;
  LAS char* V_lds = lds; LAS char* K_lds = lds + 2 * SHM_V;
  LAS float* ws = (LAS float*)(lds + 2 * SHM_V + 2 * SHM_K) + wid * 64; LAS float* li_l = ws; LAS float* al_l = ws + 32;
  float m_reg = 0.f, l_reg = 0; f32x16 o[4] = {}; bf16x8 qr[12]; f32x16 minit = {};
  const int sr = tid >> 4, sc = (tid & 15) * 8, vst0 = v_st(sr, sc), vst1 = v_st(32 + sr, sc);
  int krow[3], kcb[3];
#pragma unroll
  for (int i = 0; i < 3; ++i) { const int id = tid + 512 * i; krow[i] = id / 24; kcb[i] = (id - krow[i] * 24) * 16; }
  const int vb0 = (int)(uintptr_t)V_lds + v_rd_base(lane);
  u32x4 vs0, vs1, ks0, ks1, ks2;
#define SLOAD(k0) do { vs0 = *(const u32x4*)(Vh + (long)((k0) + sr) * LDV + sc); vs1 = *(const u32x4*)(Vh + (long)((k0) + 32 + sr) * LDV + sc); \
    ks0 = *(const u32x4*)((const char*)(Kh + (long)((k0) + krow[0]) * LDK) + kcb[0]); ks1 = *(const u32x4*)((const char*)(Kh + (long)((k0) + krow[1]) * LDK) + kcb[1]); \
    ks2 = *(const u32x4*)((const char*)(Kh + (long)((k0) + krow[2]) * LDK) + kcb[2]); } while (0)
#define SWRITE(b) do { *(LAS u32x4*)(V_lds + (b) * SHM_V + vst0) = vs0; *(LAS u32x4*)(V_lds + (b) * SHM_V + vst1) = vs1; \
    *(LAS u32x4*)(K_lds + (b) * SHM_K + KSWZ(krow[0], kcb[0])) = ks0; *(LAS u32x4*)(K_lds + (b) * SHM_K + KSWZ(krow[1], kcb[1])) = ks1; \
    *(LAS u32x4*)(K_lds + (b) * SHM_K + KSWZ(krow[2], kcb[2])) = ks2; } while (0)
#define SWAIT() asm volatile("s_waitcnt vmcnt(0)" ::: "memory")
#define RESC(a) do { if (__any((a) < 1.f)) { if (hi == 0) al_l[r32] = (a); asm volatile("s_waitcnt lgkmcnt(0)" ::: "memory"); \
    _Pragma("unroll") for (int d = 0; d < 4; ++d) _Pragma("unroll") for (int r = 0; r < 16; ++r) o[d][r] *= al_l[crow(r, hi)]; } } while (0)
  f32x16 p0, p1; float al; bf16x8 pa0, pa1, pa2, pa3; const int NT = seq / KVBLK;
  {
    const u32x4 t0v0 = *(const u32x4*)(Vh + (long)(sr) * LDV + sc), t0v1 = *(const u32x4*)(Vh + (long)(32 + sr) * LDV + sc);
    const u32x4 t0k0 = *(const u32x4*)((const char*)(Kh + (long)(krow[0]) * LDK) + kcb[0]), t0k1 = *(const u32x4*)((const char*)(Kh + (long)(krow[1]) * LDK) + kcb[1]), t0k2 = *(const u32x4*)((const char*)(Kh + (long)(krow[2]) * LDK) + kcb[2]);
    SLOAD(KVBLK);
    const bf16_t* Qw = Qb + (long)(wid * QBLK + r32) * LDQ + hi * 8;
  #pragma unroll
    for (int d0 = 0; d0 < 12; ++d0) qr[d0] = *reinterpret_cast<const bf16x8*>(Qw + d0 * 16);
    if (t0 >= 0) { const int t = t0 + wid * QBLK + r32; const int pr = t >> 6, pc = t & 63;
      const f32x4 cr0 = *(const f32x4*)(MC + pr * 16 + hi * 8), cr1 = *(const f32x4*)(MC + pr * 16 + hi * 8 + 4), sr0 = *(const f32x4*)(MS + pr * 16 + hi * 8), sr1 = *(const f32x4*)(MS + pr * 16 + hi * 8 + 4);
      const f32x4 cc0 = *(const f32x4*)(MC + pc * 16 + hi * 8), cc1 = *(const f32x4*)(MC + pc * 16 + hi * 8 + 4), sc0 = *(const f32x4*)(MS + pc * 16 + hi * 8), sc1 = *(const f32x4*)(MS + pc * 16 + hi * 8 + 4);
      rope8(qr[8], qr[10], cr0, cr1, sr0, sr1); rope8(qr[9], qr[11], cc0, cc1, sc0, sc1); }
    SWAIT();
    *(LAS u32x4*)(V_lds + vst0) = t0v0; *(LAS u32x4*)(V_lds + vst1) = t0v1;
    *(LAS u32x4*)(K_lds + KSWZ(krow[0], kcb[0])) = t0k0; *(LAS u32x4*)(K_lds + KSWZ(krow[1], kcb[1])) = t0k1; *(LAS u32x4*)(K_lds + KSWZ(krow[2], kcb[2])) = t0k2;
    SWRITE(1); __syncthreads(); }
#pragma unroll 1
  for (int j = 0; j < NT; ++j) {
    const int buf = j & 1;
    if (j + 2 < NT) SLOAD((j + 2) * KVBLK);
    SBAR(); qkt(p0, p1, K_lds + buf * SHM_K, qr, r32, hi, minit);
    partialSM(p0, p1, m_reg, al, minit, j == 0);
    RESC(al);
    finishSM(p0, p1, al, l_reg, pa0, pa1, pa2, pa3); SBAR();
    pv_d0(o, vb0 + buf * SHM_V, pa0, pa1, pa2, pa3);
    __syncthreads();
    if (j + 2 < NT) { SWAIT(); SWRITE(buf); }
  }
  if (hi == 0) li_l[r32] = l_reg; asm volatile("s_waitcnt lgkmcnt(0)" ::: "memory");
  float rli[16];
#pragma unroll
  for (int r = 0; r < 16; ++r) rli[r] = __builtin_amdgcn_rcpf(li_l[crow(r, hi)]);
  bf16_t* Ow = Ob + (long)(wid * QBLK) * LDO;
#pragma unroll
  for (int r = 0; r < 16; ++r) { const int orow = crow(r, hi);
#pragma unroll
    for (int d0 = 0; d0 < 4; ++d0) Ow[(long)orow * LDO + d0 * 32 + r32] = (bf16_t)(cvtpk(o[d0][r] * rli[r], 0.f) & 0xffffu); }
#undef SLOAD
#undef SWRITE
#undef SWAIT
#undef RESC
}
}

DI void phase_mla_attn(const Ctx& F) {
    const bf16_t* MQ = (const bf16_t*)(F.S() + S_MQ); const bf16_t* KK = (const bf16_t*)(F.S() + S_KK); const bf16_t* VV = (const bf16_t*)(F.S() + S_VV); bf16_t* AO = (bf16_t*)(F.S() + S_AO);
    const int c = F.bid, xcd = c & 7, jx = c >> 3;
    const int nlat = NB * 8 * 16, nctx = NB * 8;
#pragma unroll 1
    for (int i = 0; ; ++i) {
        int u = i * F.G + c;
        if (u >= nlat + nctx) break;
        int bh, seq, t0; size_t qrow;
        if (u < nlat) {
            if (F.G == 256) u = (((i * 2 + (jx >> 4)) * 8 + xcd) << 4) | (jx & 15);
            bh = u >> 4; const int qb = u & 15; qrow = (size_t)NCTX + (size_t)(bh >> 3) * 4096 + qb * 256; seq = KVLEN; t0 = qb * 256;
        } else { bh = u - nlat; qrow = (size_t)(bh >> 3) * 256; seq = CTXL; t0 = -1; }
        const int h = bh & 7;
        __syncthreads();
        att::attn_body(MQ + qrow * 1536 + h * 192, KK + (size_t)bh * KVLEN * 192, VV + (size_t)bh * KVLEN * 128, AO + qrow * 1024 + h * 128, seq, t0, F.MC(), F.MS(), (LAS char*)F.lds, F.wave);
    }
}
using pg8::Gemm; using pg8::StaticOrder; using pg8::GroupedOrder; using pg8::gemm_phase;
#define GEMM_LDS(F) ((LAS unsigned char*)(F).lds)
template <class Epi> DI void run_gemm(const Ctx& F, const bf16_t* A, const bf16_t* Bt, int M, int N, int K, const Epi& E, int pm0 = 0, bool rev = false) {
    Gemm g{A, Bt, M, N, K}; StaticOrder S; S.init(M - pm0 * 256, N, F.G, rev ? F.G - 1 - F.bid : F.bid); S.pm0 = pm0;
    gemm_phase<Epi, StaticOrder, false>(GEMM_LDS(F), g, S, E, nullptr, F.wave);
}
constexpr int MOE_TAB = 131072;
constexpr int MOE_ROWTAB = MOE_TAB + 4096;
template <class Epi, bool GATHER> DI void run_moe_gemm(const Ctx& F, int l, const bf16_t* A, const bf16_t* Bt, int K, const Epi& E) {
    LAS int* ps = (LAS int*)(F.lds + MOE_TAB); LAS int* cnt = (LAS int*)(F.lds + MOE_TAB + 256); LAS int* tile_e = (LAS int*)(F.lds + MOE_TAB + 512); LAS int* rowtab = (LAS int*)(F.lds + MOE_ROWTAB);
    moe_prefix(F, l, ps, cnt);
    const int ntile = ps[32] >> 8;
    if (F.tid < 32) { const int e = F.tid; for (int t = ps[e] >> 8; t < (ps[e + 1] >> 8); ++t) tile_e[t] = e; }
    {
        const int* rowtok = (const int*)(F.ws + WS_ROWTOK); const float* roww = (const float*)(F.ws + WS_ROWW); LAS float* wtab = (LAS float*)(F.lds + MOE_ROWTAB + 10240);
        const GroupedOrder S0{ntile, 4, F.G, F.bid, tile_e, rowtab};
        if ((GATHER || F.G == 256) && F.tid < 256) {
            int sv[10]; float wv[10]; bool ok[10];
#pragma unroll
            for (int ui = 0; ui < 10; ++ui) { int t, pl; ok[ui] = S0.unit_of(ui, t, pl); const int tt = ok[ui] ? t : 0; sv[ui] = rowtok[tt * 256 + F.tid]; wv[ui] = GATHER ? 0.f : roww[tt * 256 + F.tid]; }
#pragma unroll
            for (int ui = 0; ui < 10; ++ui) if (ok[ui]) {
                if (GATHER) rowtab[ui * 256 + F.tid] = sv[ui] >= 0 ? (sv[ui] >> 1) : 0;
                else { rowtab[ui * 256 + F.tid] = sv[ui]; wtab[ui * 256 + F.tid] = wv[ui] * (64.0f / (FP8_SH * FP8_SW)); } }
        }
    }
    __syncthreads();
    Gemm g{A, Bt, MAXROWS, 1024, K / 2}; GroupedOrder S{ntile, 4, F.G, F.bid, tile_e, rowtab};
    gemm_phase<Epi, GroupedOrder, false, GATHER, true>(GEMM_LDS(F), g, S, E, nullptr, F.wave);
}

__global__ void __launch_bounds__(NTHREADS, 2) mega_fwd(Params prm) {
    extern __shared__ __attribute__((aligned(16))) unsigned char lds_raw[];
    Ctx F; F.lds = (LAS unsigned char*)lds_raw; F.tid = threadIdx.x; F.lane = F.tid & 63; F.wave = __builtin_amdgcn_readfirstlane(F.tid >> 6); F.G = gridDim.x; F.bid = blockIdx.x; F.ws = F.wsp();
    if (F.tid == 0) { *(LAS u32x4*)(F.lds + XB_LDS_OFF) = (u32x4){0u, 0u, 0u, 0u}; *(LAS u32x4*)(F.lds + XB_LDS_OFF - 16) = (u32x4){0u, 0u, 0u, 0u}; }
    __syncthreads();
    XcdBarrier bar = xcd_barrier_post((unsigned*)(F.ws + WS_CTL), (volatile LAS unsigned*)(F.lds + XB_LDS_OFF));
#ifndef PROBE_GROUP
#define PROBE_GROUP 0
#endif
#define PH_T0() do { if (PROBE_GROUP != 0 && blockIdx.x == 0 && threadIdx.x == 0) *(LAS unsigned long long*)(F.lds + XB_LDS_OFF - 16) = __builtin_amdgcn_s_memrealtime(); } while (0)
#define PH_T1(grp) do { if (PROBE_GROUP != 0 && ((grp) == PROBE_GROUP || (PROBE_GROUP == 99 && ((grp) == 4 || (grp) == 5 || (grp) == 7 || (grp) == 8 || (grp) == 9))) && blockIdx.x == 0 && threadIdx.x == 0) *(LAS unsigned long long*)(F.lds + XB_LDS_OFF - 8) += __builtin_amdgcn_s_memrealtime() - *(LAS unsigned long long*)(F.lds + XB_LDS_OFF - 16); } while (0)
#define GRID_BAR() do { __syncthreads(); XcdBarrier b2 = bar; asm volatile("" : "+s"(b2.bar), "+s"(b2.x)); b2.bar = (unsigned*)(__attribute__((address_space(1))) unsigned*)b2.bar; xcd_barrier(b2); } while (0)

#define PHASE(grp, ...) do { PH_T0(); __VA_ARGS__; GRID_BAR(); PH_T1(grp); } while (0)
    PHASE(8, phase_mod(F.fresh()); phase_tables(F.fresh()); phase_wconv(F.fresh(), 0));
    {   LAS unsigned* xw = (LAS unsigned*)(F.lds + XB_LDS_OFF);
        if (threadIdx.x == 0) { unsigned* cen = (unsigned*)(F.ws + WS_CTL); unsigned nx = 0, myidx = 0, ok = 1; const unsigned per = (unsigned)F.G >> 3;
            for (unsigned j = 0; j < 16; ++j) { const unsigned c = xb_ld(&cen[XB_XCNT(j)]); if (c) { if (j == bar.x) myidx = nx; ++nx; if (c != per) ok = 0; } }
            const unsigned rank = xw[2]; ok = ok && (nx == 8u) && (per * 8u == (unsigned)F.G) && (rank < per);
            xw[3] = ok ? (rank * 8u + myidx) : (unsigned)blockIdx.x; }
        __syncthreads();
        F.bid = __builtin_amdgcn_readfirstlane((int)xw[3]);
    }
    PHASE(8, phase_u0(F.fresh()));

#pragma unroll 1
    for (int l = 0; l < DEPTH; ++l) {
        const int kind = l % 3, jl = l / 3; const bool lastl = (l == DEPTH - 1);
        if (kind == 0) {
            PHASE(1, run_gemm(F.fresh(), F.U(), F.WMIX() + WM_RET_IN, NTOK, 4096, 1024, pg8::EpiRetQKV{(bf16_t*)(F.S() + S_QKV), F.RC(), F.RS()}));
            PHASE(2, phase_ret_scan(F.fresh(), jl));
            PHASE(2, phase_stats_fin(F.fresh()));
            PHASE(1, run_gemm(F.fresh(), F.U(), F.WMIX() + WM_RET_IN + (size_t)4096 * 1024, NTOK, 2048, 1024, pg8::EpiRetGate{(bf16_t*)(F.S() + S_O), (const float*)(F.ws + WS_MR), F.in(10) + (size_t)jl * 2048}, lastl ? 16 : 0));
            PHASE(1, run_gemm(F.fresh(), (const bf16_t*)(F.S() + S_O), F.WMIX() + WM_RET_OUT, NTOK, 1024, 2048, pg8::EpiBf16Plain{(bf16_t*)(F.S() + S_QKV), 1024}, lastl ? 16 : 0));
        } else if (kind == 1) {
            PHASE(1, run_gemm(F.fresh(), F.U(), F.WMIX() + WM_MLA_DOWN, NTOK, 768, 1024, pg8::EpiBf16Plain{(bf16_t*)(F.S() + S_DWN), 768}));
            PHASE(9, phase_mla_prep(F.fresh()));
            PHASE(1, run_gemm(F.fresh(), (const bf16_t*)(F.S() + S_DQ), F.WMIX() + WM_MLA_UQ, NTOK, 1536, 384, pg8::EpiBf16Plain{(bf16_t*)(F.S() + S_MQ), 1536});
                     run_gemm(F.fresh(), (const bf16_t*)(F.S() + S_DKV), F.WMIX() + WM_MLA_UKV, NTOK, 2048, 256, pg8::EpiMlaKV{(bf16_t*)(F.S() + S_KK), (bf16_t*)(F.S() + S_VV)}, 0, true));
            PHASE(3, phase_mla_attn(F.fresh()));
            PHASE(1, run_gemm(F.fresh(), (const bf16_t*)(F.S() + S_AO), F.WMIX() + WM_MLA_OUT, NTOK, 1024, 1024, pg8::EpiBf16Plain{(bf16_t*)(F.S() + S_MQ), 1024}));
        } else {
            PHASE(1, run_gemm(F.fresh(), F.U(), F.WMIX() + WM_CONV_IN, NTOK, 3072, 1024, pg8::EpiConvIn{(bf16_t*)(F.S() + S_GB), (bf16_t*)(F.S() + S_PB)}));
            PHASE(9, phase_conv(F.fresh()));
            PHASE(1, run_gemm(F.fresh(), (const bf16_t*)(F.S() + S_A2), F.WMIX() + WM_CONV_OUT, NTOK, 1024, 1024, pg8::EpiBf16Plain{(bf16_t*)(F.S() + S_PB), 1024}));
        }
        const int r0 = lastl ? NCTX : 0, rpb = lastl ? NLAT / 256 : NTOK / 256;
        PHASE(4, phase_ln1_router(F.fresh(), l, (const bf16_t*)(F.S() + (kind == 0 ? S_QKV : (kind == 1 ? S_MQ : S_PB))), r0, rpb));
        PHASE(5, phase_moe_pos(F.fresh(), l, r0));
        PHASE(6, run_moe_gemm<pg8::EpiMoe1, true>(F.fresh(), l, F.U(), F.W13(), 1024, pg8::EpiMoe1{(unsigned char*)(F.S() + S_HDN)}));
        PHASE(6, run_moe_gemm<pg8::EpiMoe2, false>(F.fresh(), l, (const bf16_t*)(F.S() + S_HDN), F.W2(), 512, pg8::EpiMoe2{(unsigned char*)(F.S() + S_YS), (const int*)(F.ws + WS_ROWTOK), (const float*)(F.ws + WS_ROWW), (const LAS int*)(F.lds + MOE_ROWTAB), (const LAS float*)(F.lds + MOE_ROWTAB + 10240), F.G == 256}));
        PH_T0();
        phase_ln2(F.fresh(), l, r0, rpb);
        if (l + 1 < DEPTH) { phase_wconv(F.fresh(), l + 1); GRID_BAR(); }
        PH_T1(7);
    }
    if (PROBE_GROUP != 0 && blockIdx.x == 0 && threadIdx.x == 0) {
        const unsigned long long t0 = __builtin_amdgcn_s_memrealtime(), dt = 4ull * *(LAS unsigned long long*)(F.lds + XB_LDS_OFF - 8);
        while (__builtin_amdgcn_s_memrealtime() - t0 < dt) __builtin_amdgcn_s_sleep(8);
    }
}

extern "C" void kernel_launch(void* const* d_in, const int* in_sizes, int n_in, void* d_out, int out_size, void* d_ws, size_t ws_size, hipStream_t stream) {
    static int grid = 0;
    if (grid == 0) {
        if (n_in != 29 || out_size != NLAT * DM || ws_size < WS_END) { fprintf(stderr, "kernel_launch: unexpected shapes: n_in %d out %d ws %zu (need %zu)\n", n_in, out_size, ws_size, (size_t)WS_END); grid = -1; return; }
        int dev = 0, cus = 0, per_cu = 0;
        if (hipGetDevice(&dev) != hipSuccess || hipDeviceGetAttribute(&cus, hipDeviceAttributeMultiprocessorCount, dev) != hipSuccess) { grid = -1; return; }
        if (hipFuncSetAttribute((const void*)mega_fwd, hipFuncAttributeMaxDynamicSharedMemorySize, LDS_BYTES) != hipSuccess) { fprintf(stderr, "kernel_launch: hipFuncSetAttribute failed\n"); grid = -1; return; }
        if (hipOccupancyMaxActiveBlocksPerMultiprocessor(&per_cu, (const void*)mega_fwd, NTHREADS, LDS_BYTES) != hipSuccess || per_cu < 1) { fprintf(stderr, "kernel_launch: occupancy query says %d\n", per_cu); }
        (void)hipGetLastError();
        grid = cus;
    }
    if (grid < 0) return;
    (void)in_sizes;
    hipMemsetAsync((char*)d_ws + WS_CTL, 0, CTL_BYTES, stream);
    Params p{};
    for (int i = 0; i < 29; ++i) p.in[i] = (const float*)d_in[i];
    p.out = (float*)d_out; p.ws = (unsigned char*)d_ws;
    hipLaunchKernelGGL(mega_fwd, dim3(grid), dim3(NTHREADS), LDS_BYTES, stream, p);
}
```

```cpp
#ifndef PROBE_GROUP
#define PROBE_GROUP 0
#endif
#include <hip/hip_runtime.h>
#include <cstdio>
#include <cstdint>

#define DI __device__ __forceinline__
#define LAS __attribute__((address_space(3)))
#define PG8_LAS LAS
typedef unsigned short bf16_t;
typedef short bf16x8 __attribute__((ext_vector_type(8)));
typedef short s16x4 __attribute__((ext_vector_type(4)));
typedef float f32x4 __attribute__((ext_vector_type(4)));
typedef float f32x2 __attribute__((ext_vector_type(2)));
typedef float f32x8 __attribute__((ext_vector_type(8)));
typedef float f32x16 __attribute__((ext_vector_type(16)));
typedef unsigned u32x4 __attribute__((ext_vector_type(4)));
typedef int i32x4 __attribute__((ext_vector_type(4)));
typedef int i32x8 __attribute__((ext_vector_type(8)));
typedef unsigned u32x2 __attribute__((ext_vector_type(2)));

constexpr int DM = 1024, NB = 16, SEQ = 4096, CTXL = 256, DEPTH = 4;
constexpr int NCTX = NB * CTXL, NLAT = NB * SEQ, NTOK = NCTX + NLAT;
constexpr float ALPHA = 1.6817928305074292f;
constexpr float LN_EPS = 1e-5f, RMS_EPS = 1e-6f;
constexpr int NEXP = 32, MOE_H = 512;
constexpr int NSLOT = 2 * NTOK;
constexpr int MAXROWS = 147456;
constexpr int KVLEN = CTXL + SEQ;
constexpr int LDS_BYTES = 163840;
constexpr int XB_LDS_OFF = LDS_BYTES - 16;
constexpr int NTHREADS = 512;

constexpr size_t al256(size_t x) { return (x + 255) / 256 * 256; }
constexpr size_t WS_CTL   = 0;
constexpr size_t CTL_BYTES = 32768;
constexpr size_t CTL_GCOUNT = 16384;
constexpr size_t WS_MOD   = WS_CTL + CTL_BYTES;
constexpr size_t WS_ROPE  = al256(WS_MOD + (size_t)4 * 17 * 6144 * 4);
constexpr size_t WS_H16   = al256(WS_ROPE + (size_t)(2 * 4096 + 2 * 1024) * 4);
constexpr size_t WS_U     = al256(WS_H16 + (size_t)NTOK * DM * 2);
constexpr size_t WS_WMIX  = al256(WS_U + (size_t)NTOK * DM * 2);
constexpr size_t WMIX_ELEMS = (size_t)6144 * 1024 + (size_t)1024 * 2048;
constexpr size_t WS_W13   = al256(WS_WMIX + WMIX_ELEMS * 2);
constexpr size_t WS_W2    = al256(WS_W13 + (size_t)32 * 1024 * 1024 * 2);
constexpr size_t WS_SLOTE = al256(WS_W2 + (size_t)32 * 1024 * 512 * 2);
constexpr size_t WS_SLOTR = al256(WS_SLOTE + (size_t)NSLOT * 4);
constexpr size_t WS_SLOTW = al256(WS_SLOTR + (size_t)NSLOT * 4);
constexpr size_t WS_ROWTOK = al256(WS_SLOTW + (size_t)NSLOT * 4);
constexpr size_t WS_ROWW  = al256(WS_ROWTOK + (size_t)MAXROWS * 4);
constexpr size_t WS_STATS = al256(WS_ROWW + (size_t)MAXROWS * 4);
constexpr size_t WS_MR    = al256(WS_STATS + (size_t)NTOK * 4 * 16 * 4);
constexpr size_t WS_S     = al256(WS_MR + (size_t)NTOK * 4 * 2 * 4);
constexpr size_t S_QKV = 0;
constexpr size_t S_O   = (size_t)NTOK * 4096 * 2;
constexpr size_t S_RET_END = S_O + (size_t)NTOK * 2048 * 2;
constexpr size_t S_DWN = 0;
constexpr size_t S_DQ  = al256(S_DWN + (size_t)NTOK * 768 * 2);
constexpr size_t S_DKV = al256(S_DQ + (size_t)NTOK * 384 * 2);
constexpr size_t S_AO  = 0;
constexpr size_t S_MQ  = al256(S_DKV + (size_t)NTOK * 256 * 2);
constexpr size_t S_KK  = al256(S_MQ + (size_t)NTOK * 1536 * 2);
constexpr size_t S_VV  = al256(S_KK + (size_t)NB * 8 * KVLEN * 192 * 2);
constexpr size_t S_MLA_END = S_VV + (size_t)NB * 8 * KVLEN * 128 * 2;
static_assert(S_MQ >= (size_t)NTOK * 1024 * 2, "AO alias fits");
constexpr size_t S_PB = 0, S_GB = (size_t)NTOK * 1024 * 2, S_A2 = 2 * S_GB, S_CONV_END = 3 * S_GB;
constexpr size_t S_XS  = 0;
constexpr size_t S_HDN = (size_t)MAXROWS * 1024 * 2;
constexpr size_t S_YS  = S_HDN + (size_t)MAXROWS * 512 * 2;
constexpr size_t S_MOE_END = S_YS + (size_t)NSLOT * 1024 * 2;
constexpr size_t cmax(size_t a, size_t b) { return a > b ? a : b; }
constexpr size_t S_BYTES = cmax(cmax(S_RET_END, S_MLA_END), cmax(S_CONV_END, S_MOE_END));
constexpr size_t WS_END = WS_S + S_BYTES;

struct Params { const float* in[29]; float* out; unsigned char* ws; };

DI int lane_id_fresh() { int l; asm volatile("v_mbcnt_lo_u32_b32 %0, -1, 0\n\tv_mbcnt_hi_u32_b32 %0, -1, %0" : "=v"(l)); return l; }
DI float bf2f(unsigned short x) { return __uint_as_float(((unsigned)x) << 16); }
DI unsigned cvt_pk_bf16(float lo, float hi) { unsigned r; asm volatile("v_cvt_pk_bf16_f32 %0, %1, %2" : "=v"(r) : "v"(lo), "v"(hi)); return r; }
DI float bflo(unsigned w) { return __uint_as_float(w << 16); }
DI float bfhi(unsigned w) { return __uint_as_float(w & 0xffff0000u); }
DI float wave_sum(float v) {
#pragma unroll
    for (int m = 32; m >= 1; m >>= 1) v += __shfl_xor(v, m, 64);
    return v;
}
typedef _Float16 h16x4 __attribute__((ext_vector_type(4)));
DI u32x2 pack_h4(const f32x4& v) { const h16x4 h = __builtin_convertvector(v, h16x4); return __builtin_bit_cast(u32x2, h); }
DI f32x4 unpack_h4(const u32x2& w) { const h16x4 h = __builtin_bit_cast(h16x4, w); return __builtin_convertvector(h, f32x4); }
DI float silu_f(float a) { return a * __builtin_amdgcn_rcpf(1.0f + __expf(-a)); }
DI u32x4 pack8(const f32x4& a, const f32x4& b) { u32x4 w; w.x = cvt_pk_bf16(a[0], a[1]); w.y = cvt_pk_bf16(a[2], a[3]); w.z = cvt_pk_bf16(b[0], b[1]); w.w = cvt_pk_bf16(b[2], b[3]); return w; }
static_assert(WS_END <= 1287462016ull, "workspace budget (guaranteed >= sum of inputs = 1.287 GB)");
constexpr float FP8_SU = 8.0f;
constexpr float FP8_SW = 256.0f;
constexpr float FP8_SH = 8.0f;
DI unsigned pack_fp8x4(const f32x4& v) { int w = 0; w = __builtin_amdgcn_cvt_pk_fp8_f32(v[0], v[1], w, false); w = __builtin_amdgcn_cvt_pk_fp8_f32(v[2], v[3], w, true); return (unsigned)w; }
DI f32x4 clamp_fp8(const f32x4& v) { f32x4 r;
#pragma unroll
    for (int j = 0; j < 4; ++j) r[j] = __builtin_amdgcn_fmed3f(v[j], -440.0f, 440.0f);
    return r; }
#define XB_TMO      128
#define XB_XCNT(j)  (256  + 64 * (j))
#define XB_XSUB(j)  (1280 + 64 * (j))
#define XB_XGEN(j)  (2304 + 64 * (j))
#define XB_TOP      3328
#define XB_TOPGEN   3392
#define XCD_BAR_WORDS 3456
#define XB_SPIN_CAP (1u << 20)

__device__ __forceinline__ unsigned xb_ld(unsigned* p)              { return __hip_atomic_load((__attribute__((address_space(1))) unsigned*)p, __ATOMIC_RELAXED, __HIP_MEMORY_SCOPE_AGENT); }
__device__ __forceinline__ unsigned xb_add(unsigned* p, unsigned v) { return __hip_atomic_fetch_add((__attribute__((address_space(1))) unsigned*)p, v, __ATOMIC_RELAXED, __HIP_MEMORY_SCOPE_AGENT); }
__device__ __forceinline__ unsigned xb_xcc_id() { return (unsigned)__builtin_amdgcn_s_getreg((3 << 11) | 20) & 0xFu; }
#define XB_SPIN(cond, bar) do { unsigned _sp = 0; while (cond) { __builtin_amdgcn_s_sleep(1); \
    if ((++_sp & 255u) == 0u) { if (xb_ld(&(bar)[XB_TMO])) break; if (_sp > XB_SPIN_CAP) { atomicAdd(&(bar)[XB_TMO], 1u); break; } } } } while (0)

struct XcdBarrier {
    unsigned* bar; unsigned x;
    volatile LAS unsigned* st;
};

__device__ __forceinline__ XcdBarrier xcd_barrier_post(unsigned* bar, volatile LAS unsigned* st) {
    XcdBarrier b; b.bar = bar; b.x = xb_xcc_id(); b.st = st;
    if (threadIdx.x == 0) st[2] = xb_add(&bar[XB_XCNT(b.x)], 1u);
    return b;
}
__device__ __forceinline__ void xcd_barrier_complete(unsigned* bar, unsigned x, unsigned& nloc, unsigned& nx) {
    const unsigned G = gridDim.x * gridDim.y * gridDim.z;
    unsigned sum, cnt, mine, sp = 0u;
    for (;;) {
        sum = 0u; cnt = 0u; mine = 0u;
#pragma unroll
        for (unsigned j = 0; j < 16; ++j) { const unsigned c = xb_ld(&bar[XB_XCNT(j)]); sum += c; cnt += (c > 0u) ? 1u : 0u; mine = (j == x) ? c : mine; }
        if (sum == G) break;
        __builtin_amdgcn_s_sleep(1);
        if ((++sp & 255u) == 0u) { if (xb_ld(&bar[XB_TMO])) break; if (sp > XB_SPIN_CAP) { atomicAdd(&bar[XB_TMO], 1u); break; } }
    }
    nloc = mine > 0u ? mine : 1u; nx = cnt > 0u ? cnt : 1u;
}

__device__ __forceinline__ void xcd_barrier(const XcdBarrier& b) {
    asm volatile("s_waitcnt vmcnt(0)" ::: "memory");
    __syncthreads();
    if (threadIdx.x == 0) {
        unsigned* bar = b.bar;
        __builtin_amdgcn_s_waitcnt(0);
        unsigned nloc = b.st[0], nx = b.st[1];
        if (nloc == 0u) { xcd_barrier_complete(bar, b.x, nloc, nx); b.st[0] = nloc; b.st[1] = nx; }
        const unsigned old = xb_add(&bar[XB_XSUB(b.x)], 1u);
        const unsigned gen = old / nloc;
        if (old + 1u == (gen + 1u) * nloc) {
            __builtin_amdgcn_fence(__ATOMIC_RELEASE, "agent");
            asm volatile("s_waitcnt vmcnt(0)" ::: "memory");
            const unsigned og = xb_add(&bar[XB_TOP], 1u);
            const unsigned tg = og / nx;
            if (og + 1u == (tg + 1u) * nx) xb_add(&bar[XB_TOPGEN], 1u);
            else XB_SPIN(xb_ld(&bar[XB_TOPGEN]) == tg, bar);
            __builtin_amdgcn_fence(__ATOMIC_ACQUIRE, "agent");
            xb_add(&bar[XB_XGEN(b.x)], 1u);
            asm volatile("s_waitcnt vmcnt(0)" ::: "memory");
        } else {
            XB_SPIN(xb_ld(&bar[XB_XGEN(b.x)]) == gen, bar);
            __builtin_amdgcn_fence(__ATOMIC_ACQUIRE, "agent");
            asm volatile("s_waitcnt vmcnt(0)" ::: "memory");
        }
    }
    __syncthreads();
}
namespace pg8 {
constexpr int BM = 256, BK = 64, HALF = 128, HTB = HALF * BK * 2  , STAGE_BYTES = 8 * HTB, NXCD = 8, WGM = 8;

__host__ __device__ __forceinline__ int lds_byte(int r, int c) { const int st = (r >> 4) * 2 + (c >> 5), rr = r & 15, cc = c & 31, ob = rr * 64 + cc * 2; return st * 1024 + (ob ^ (((ob >> 9) & 1) << 5)); }
__host__ __device__ __forceinline__ void stage_rc(int b, int& R, int& C) { const int st = b / 1024, sb = b % 1024, swz = sb ^ (((sb >> 9) & 1) << 5); R = (st >> 1) * 16 + swz / 64; C = (st & 1) * 32 + (swz % 64) / 2; }
__host__ __device__ __forceinline__ int perm32(int rho) { const int n = rho >> 4, i = rho & 15; return 8 * (i >> 2) + 4 * n + (i & 3); }

struct Unit { int pm, pn; };
struct Gemm { const bf16_t* A; const bf16_t* Bt; int M, N, K; };

struct StaticOrder {
    int nM, nN, nwg, G, c, pm0 = 0;
    __host__ __device__ void init(int M, int N, int G_, int c_) { nM = M / BM; nN = N / BM; nwg = nM * nN; G = G_; c = c_; }
    __host__ __device__ bool next(int i, Unit& u) const {
        const long L = (long)i * G + c; if (L >= nwg) return false;
        int wgid = (int)L; { const int q = nwg / NXCD, r = nwg % NXCD, xcd = wgid % NXCD, off = wgid / NXCD; wgid = (xcd < r ? xcd * (q + 1) : r * (q + 1) + (xcd - r) * q) + off; }
        const int nig = WGM * nN, gid = wgid / nig, fm = gid * WGM, gsz = (nM - fm) < WGM ? (nM - fm) : WGM;
        u.pm = pm0 + fm + ((wgid % nig) % gsz); u.pn = (wgid % nig) / gsz; return true;
    }
    __device__ __forceinline__ void a_ready(const Unit&) const {}
    __device__ __forceinline__ void done(const Unit&) const {}
};
struct GroupedOrder {
    int ntile, ncol, G, c; const LAS int* tile_e; const LAS int* rowtab;
    __device__ __forceinline__ bool unit_of(int i, int& t, int& pl) const {
        if (G == 256 && ncol == 4) { const int x = c & 7, j = c >> 3; t = i * 64 + x * 8 + (j >> 2); pl = j & 3; return t < ntile; }
        const int L = i * G + c; t = L / ncol; pl = L - t * ncol; return L < ntile * ncol;
    }
    __device__ __forceinline__ bool next(int i, Unit& u) const { int t, pl; if (!unit_of(i, t, pl)) return false; u.pm = t; u.pn = tile_e[t] * ncol + pl; return true; }
    __device__ __forceinline__ void a_ready(const Unit&) const {}
    __device__ __forceinline__ void done(const Unit&) const {}
};

#define EPI_ARGS const f32x4 (&acc)[2][2][4][2], const Unit& u, int wr, int wc, int fr, int fq

struct EpiBf16Plain { static constexpr bool PERM = true, AFTER_DRAIN = false;
    bf16_t* O; int ldc;
    DI void operator()(EPI_ARGS) const {
        const int row0 = u.pm * BM + wr * 64 + fr, col0 = u.pn * BM + wc * 32 + 8 * fq;
#pragma unroll
        for (int ai = 0; ai < 2; ++ai)
#pragma unroll
            for (int m = 0; m < 4; ++m) { bf16_t* rowp = O + (size_t)(row0 + ai * HALF + m * 16) * ldc + col0;
#pragma unroll
                for (int bj = 0; bj < 2; ++bj) *(u32x4*)(rowp + bj * HALF) = pack8(acc[ai][bj][m][0], acc[ai][bj][m][1]); }
    }
};

struct EpiRetQKV { static constexpr bool PERM = true, AFTER_DRAIN = false;
    bf16_t* QKV; const float* RC; const float* RS;
    DI void operator()(EPI_ARGS) const {
        const int row0 = u.pm * BM + wr * 64 + fr, cb = wc * 32 + 8 * fq;
        const bool rope = (u.pn < 8) && (u.pm >= 16); const float ksc = (u.pn >= 4 && u.pn < 8) ? 0.0625f : 1.0f;
        const int f0 = (wc & 1) * 32 + 8 * fq;
        f32x4 c0[4], c1[4], s0[4], s1[4];
#define RQ_TAB(m, rowx) do { const int t = ((rowx) - NCTX) & 4095; const int p = (wc < 2) ? (t >> 6) : (t & 63); \
            c0[m] = *(const f32x4*)(RC + p * 64 + f0); c1[m] = *(const f32x4*)(RC + p * 64 + f0 + 4); s0[m] = *(const f32x4*)(RS + p * 64 + f0); s1[m] = *(const f32x4*)(RS + p * 64 + f0 + 4); } while (0)
        if (rope) {
#pragma unroll
            for (int m = 0; m < 4; ++m) RQ_TAB(m, row0 + m * 16);
        }
#pragma unroll
        for (int ai = 0; ai < 2; ++ai) {
#pragma unroll
            for (int m = 0; m < 4; ++m) {
                const int row = row0 + ai * HALF + m * 16; bf16_t* dst = QKV + (size_t)row * 4096 + u.pn * 256 + cb;
                f32x4 x1a = acc[ai][0][m][0], x1b = acc[ai][0][m][1], x2a = acc[ai][1][m][0], x2b = acc[ai][1][m][1];
                if (rope) {
                    const f32x4 o1a = x1a * c0[m] - x2a * s0[m], o1b = x1b * c1[m] - x2b * s1[m], o2a = x1a * s0[m] + x2a * c0[m], o2b = x1b * s1[m] + x2b * c1[m];
                    x1a = o1a; x1b = o1b; x2a = o2a; x2b = o2b;
                    if (ai == 0) RQ_TAB(m, row + HALF);
                }
                x1a *= ksc; x1b *= ksc; x2a *= ksc; x2b *= ksc;
                *(u32x4*)(dst) = pack8(x1a, x1b); *(u32x4*)(dst + HALF) = pack8(x2a, x2b);
            }
        }
#undef RQ_TAB
    }
};

struct EpiRetGate { static constexpr bool PERM = true, AFTER_DRAIN = false;
    bf16_t* O; const float* MR; const float* gn;
    DI void operator()(EPI_ARGS) const {
        const int row0 = u.pm * BM + wr * 64 + fr, col0 = u.pn * BM + wc * 32 + 8 * fq, head = u.pn >> 1;
        f32x4 gv[2][2];
#pragma unroll
        for (int bj = 0; bj < 2; ++bj)
#pragma unroll
            for (int n = 0; n < 2; ++n) gv[bj][n] = *(const f32x4*)(gn + col0 + bj * HALF + 4 * n);
        u32x4 ov[4][2]; f32x2 mr[4];
#pragma unroll
        for (int m = 0; m < 4; ++m) { const int row = row0 + m * 16; mr[m] = *(const f32x2*)(MR + ((size_t)row * 4 + head) * 2);
            ov[m][0] = *(const u32x4*)(O + (size_t)row * 2048 + col0); ov[m][1] = *(const u32x4*)(O + (size_t)row * 2048 + col0 + HALF); }
#pragma unroll
        for (int ai = 0; ai < 2; ++ai) {
#pragma unroll
            for (int m = 0; m < 4; ++m) {
                const int row = row0 + ai * HALF + m * 16; const float mean = mr[m][0], rstd = mr[m][1];
                bf16_t* rowp = O + (size_t)row * 2048 + col0;
                u32x4 res[2];
#pragma unroll
                for (int bj = 0; bj < 2; ++bj) {
                    const u32x4 w = ov[m][bj];
                    f32x4 o0, o1; o0[0] = bflo(w.x); o0[1] = bfhi(w.x); o0[2] = bflo(w.y); o0[3] = bfhi(w.y); o1[0] = bflo(w.z); o1[1] = bfhi(w.z); o1[2] = bflo(w.w); o1[3] = bfhi(w.w);
                    f32x4 r0, r1;
#pragma unroll
                    for (int j = 0; j < 4; ++j) { r0[j] = silu_f(acc[ai][bj][m][0][j]) * ((o0[j] - mean) * rstd * gv[bj][0][j]); r1[j] = silu_f(acc[ai][bj][m][1][j]) * ((o1[j] - mean) * rstd * gv[bj][1][j]); }
                    res[bj] = pack8(r0, r1);
                }
                if (ai == 0) { const int rown = row + HALF; mr[m] = *(const f32x2*)(MR + ((size_t)rown * 4 + head) * 2);
                    ov[m][0] = *(const u32x4*)(O + (size_t)rown * 2048 + col0); ov[m][1] = *(const u32x4*)(O + (size_t)rown * 2048 + col0 + HALF); }
                *(u32x4*)(rowp) = res[0]; *(u32x4*)(rowp + HALF) = res[1];
            }
        }
    }
};

struct EpiResid { static constexpr bool PERM = false, AFTER_DRAIN = false;
    const float* src_c; const float* src_l; float* dst_c; float* dst_l; const float* modl; int gchunk;
    DI void operator()(EPI_ARGS) const {
        const int row0 = u.pm * BM + wr * 64 + fr, col0 = u.pn * BM + wc * 32 + 4 * fq;
        const bool lat = u.pm >= 16; const int bp = lat ? ((u.pm - 16) >> 4) : 16;
        const float* gsrc = modl + (size_t)bp * 6144 + gchunk * 1024 + col0;
        const int rr0 = lat ? row0 - NCTX : row0;
        const float* hs = (lat ? src_l : src_c) + (size_t)rr0 * DM + col0; float* hd = (lat ? dst_l : dst_c) + (size_t)rr0 * DM + col0;
        f32x4 gv[2][2];
#pragma unroll
        for (int bj = 0; bj < 2; ++bj)
#pragma unroll
            for (int n = 0; n < 2; ++n) gv[bj][n] = *(const f32x4*)(gsrc + bj * HALF + n * 16);
#pragma unroll
        for (int ai = 0; ai < 2; ++ai) {
            f32x4 h[4][2][2];
#pragma unroll
            for (int m = 0; m < 4; ++m)
#pragma unroll
                for (int bj = 0; bj < 2; ++bj)
#pragma unroll
                    for (int n = 0; n < 2; ++n) h[m][bj][n] = *(const f32x4*)(hs + (size_t)(ai * HALF + m * 16) * DM + bj * HALF + n * 16);
#pragma unroll
            for (int m = 0; m < 4; ++m)
#pragma unroll
                for (int bj = 0; bj < 2; ++bj)
#pragma unroll
                    for (int n = 0; n < 2; ++n) *(f32x4*)(hd + (size_t)(ai * HALF + m * 16) * DM + bj * HALF + n * 16) = h[m][bj][n] * ALPHA + gv[bj][n] * acc[ai][bj][m][n];
        }
    }
};

struct EpiMlaKV { static constexpr bool PERM = true, AFTER_DRAIN = false;
    bf16_t* KK; bf16_t* VV;
    DI void operator()(EPI_ARGS) const {
        const int cb = wc * 32 + 8 * fq, h = u.pn; int b, pos0;
        if (u.pm >= 16) { const int t = u.pm - 16; b = t >> 4; pos0 = CTXL + (t & 15) * 256; } else { b = u.pm; pos0 = 0; }
        const size_t kv0 = (size_t)(b * 8 + h) * KVLEN + pos0 + wr * 64 + fr;
        bf16_t* kp = KK + kv0 * 192 + cb; bf16_t* vp = VV + kv0 * 128 + cb;
#pragma unroll
        for (int ai = 0; ai < 2; ++ai)
#pragma unroll
            for (int m = 0; m < 4; ++m) { const int ro = ai * HALF + m * 16;
                *(u32x4*)(kp + ro * 192) = pack8(acc[ai][0][m][0], acc[ai][0][m][1]);
                *(u32x4*)(vp + ro * 128) = pack8(acc[ai][1][m][0], acc[ai][1][m][1]); }
    }
};

struct EpiConvIn { static constexpr bool PERM = true, AFTER_DRAIN = false;
    bf16_t* GB; bf16_t* PB;
    DI void operator()(EPI_ARGS) const {
        const int row0 = u.pm * BM + wr * 64 + fr, cb = wc * 32 + 8 * fq;
#pragma unroll
        for (int ai = 0; ai < 2; ++ai)
#pragma unroll
            for (int m = 0; m < 4; ++m) {
                const int row = row0 + ai * HALF + m * 16;
                if (u.pn < 4) { bf16_t* rowp = GB + (size_t)row * DM + u.pn * 256 + cb;
                    *(u32x4*)(rowp) = pack8(acc[ai][0][m][0], acc[ai][0][m][1]); *(u32x4*)(rowp + HALF) = pack8(acc[ai][1][m][0], acc[ai][1][m][1]); }
                else { bf16_t* rowp = PB + (size_t)row * DM + (u.pn - 4) * 128 + cb;
                    *(u32x4*)(rowp) = pack8(acc[ai][0][m][0] * acc[ai][1][m][0], acc[ai][0][m][1] * acc[ai][1][m][1]); }
            }
    }
};

struct EpiMoe1 { static constexpr bool PERM = true, AFTER_DRAIN = false;
    unsigned char* HDN;
    DI void operator()(EPI_ARGS) const {
        const int row0 = u.pm * BM + wr * 64 + fr, cb = (u.pn & 3) * 128 + wc * 32 + 8 * fq;
        constexpr float inv = 1.0f / (FP8_SU * FP8_SW);
#pragma unroll
        for (int ai = 0; ai < 2; ++ai)
#pragma unroll
            for (int m = 0; m < 4; ++m) {
                const int row = row0 + ai * HALF + m * 16; f32x4 r0, r1;
#pragma unroll
                for (int j = 0; j < 4; ++j) { r0[j] = silu_f(acc[ai][0][m][0][j] * inv) * (acc[ai][1][m][0][j] * (inv * FP8_SH)); r1[j] = silu_f(acc[ai][0][m][1][j] * inv) * (acc[ai][1][m][1][j] * (inv * FP8_SH)); }
                u32x2 o; o.x = pack_fp8x4(clamp_fp8(r0)); o.y = pack_fp8x4(clamp_fp8(r1)); *(u32x2*)(HDN + (size_t)row * MOE_H + cb) = o;
            }
    }
};

struct EpiMoe2 { static constexpr bool PERM = true, AFTER_DRAIN = false;
    unsigned char* YS; const int* rowtok; const float* roww;
    const LAS int* slotL; const LAS float* wL; bool lds_ok;
    DI void operator()(EPI_ARGS) const {
        const int row0 = u.pm * BM + wr * 64 + fr, cb = (u.pn & 3) * 256 + wc * 32 + 8 * fq;
        int slot[2][4]; float w[2][4];
#pragma unroll
        for (int ai = 0; ai < 2; ++ai)
#pragma unroll
            for (int m = 0; m < 4; ++m) { const int row = row0 + ai * HALF + m * 16;
                if (lds_ok) { const int li = (u.pm >> 6) * 256 + wr * 64 + fr + ai * HALF + m * 16; slot[ai][m] = slotL[li]; w[ai][m] = wL[li]; }
                else { slot[ai][m] = rowtok[row]; w[ai][m] = roww[row] * (64.0f / (FP8_SH * FP8_SW)); } }
#pragma unroll
        for (int ai = 0; ai < 2; ++ai)
#pragma unroll
            for (int m = 0; m < 4; ++m) {
                if (slot[ai][m] >= 0) { unsigned char* rowp = YS + (size_t)slot[ai][m] * DM + cb;
#pragma unroll
                    for (int bj = 0; bj < 2; ++bj) { u32x2 o; o.x = pack_fp8x4(clamp_fp8(acc[ai][bj][m][0] * w[ai][m])); o.y = pack_fp8x4(clamp_fp8(acc[ai][bj][m][1] * w[ai][m])); *(u32x2*)(rowp + bj * HALF) = o; } }
            }
    }
};
template <class Epi, class Sched, bool STAMP = false, bool GATHER = false, bool FP8 = false>
__device__ __forceinline__ void gemm_phase(PG8_LAS unsigned char* lds, const Gemm g, const Sched& S, const Epi& E, unsigned long long* stamps, int wave_id) {
    int tid_l = lane_id_fresh(); asm volatile("" : "+v"(tid_l)); tid_l += 64 * wave_id;
    const int tid = tid_l, wid = __builtin_amdgcn_readfirstlane(tid >> 6), lane = tid & 63, wr = wid >> 2, wc = wid & 3, fr = lane & 15, fq = lane >> 4;
    const int K = g.K, nt = K / BK;
    int ts_lo = 0, ts_hi = 0, nts = 0; const unsigned long long rt_entry = STAMP ? (unsigned long long)wall_clock64() : 0ull;
#define PG8_STAMP() do { if (STAMP && wid == 0 && nts < 64) { const unsigned long long _c = (unsigned long long)clock64(); \
        ts_lo = (lane == nts) ? (int)(unsigned)_c : ts_lo; ts_hi = (lane == nts) ? (int)(unsigned)(_c >> 32) : ts_hi; ++nts; } } while (0)
    PG8_STAMP();
    unsigned voffA[2], voffB[2];
#pragma unroll
    for (int i = 0; i < 2; ++i) { int R, C; stage_rc(tid * 16 + i * 8192, R, C); const int Rb = Epi::PERM ? ((R & ~31) + perm32(R & 31)) : R;
        voffA[i] = (unsigned)(R * K + C) * 2u; voffB[i] = (unsigned)(Rb * K + C) * 2u; }
    unsigned offC[2][2], offN[2][2]; int gC[2];
    if constexpr (GATHER) {
#pragma unroll
        for (int i = 0; i < 2; ++i) { int R, C; stage_rc(tid * 16 + i * 8192, R, C); gC[i] = C * 2 | (R << 16); }
    }
#define PG8_GOFF(dst, ui_) do { _Pragma("unroll") for (int _h = 0; _h < 2; ++_h) _Pragma("unroll") for (int _i = 0; _i < 2; ++_i) \
        dst[_h][_i] = (unsigned)S.rowtab[(ui_) * 256 + _h * 128 + (gC[_i] >> 16)] * (unsigned)(K * 2) + (unsigned)(gC[_i] & 0xffff); } while (0)
    const size_t kstep = (size_t)(BK * 2);
    const size_t hstep = (size_t)HALF * K * 2;
    const size_t tstep = 2 * hstep;
    const unsigned ldsw = (unsigned)wid * 1024u;
    const int aoff = FP8 ? lds_byte(wr * 64 + fr, fq * 16) : lds_byte(wr * 64 + fr, fq * 8), boff = FP8 ? lds_byte(wc * 32 + fr, fq * 16) : lds_byte(wc * 32 + fr, fq * 8);
#define PG8_SA(b, h) (((b) * 2 + (h)) * HTB)
#define PG8_SB(b, h) ((4 + (b) * 2 + (h)) * HTB)
#define PG8_STAGE(bufoff, gbase, voff) do { _Pragma("unroll") for (int _i = 0; _i < 2; ++_i) \
        __builtin_amdgcn_global_load_lds((const unsigned*)((const char*)(gbase) + (voff)[_i]), (PG8_LAS unsigned*)(lds + (bufoff) + ldsw + _i * 8192), 16, 0, 0); } while (0)
#define PG8_STAGE_G(bufoff, kbase, offs) do { _Pragma("unroll") for (int _i = 0; _i < 2; ++_i) \
        __builtin_amdgcn_global_load_lds((const unsigned*)((const char*)(kbase) + (offs)[_i]), (PG8_LAS unsigned*)(lds + (bufoff) + ldsw + _i * 8192), 16, 0, 0); } while (0)
#define PG8_CAT8(lo, hi) __builtin_shufflevector(__builtin_bit_cast(i32x4, lo), __builtin_bit_cast(i32x4, hi), 0, 1, 2, 3, 4, 5, 6, 7)
#define PG8_LDA(dst, b, h) do { _Pragma("unroll") for (int m = 0; m < 4; ++m) _Pragma("unroll") for (int k = 0; k < 2; ++k) { if constexpr (FP8) { if (k == 0) dst##8[m] = PG8_CAT8(*(const PG8_LAS bf16x8*)(lds + PG8_SA(b, h) + aoff + m * 2048), *(const PG8_LAS bf16x8*)(lds + PG8_SA(b, h) + aoff + m * 2048 + 16)); } else dst[m][k] = *(const PG8_LAS bf16x8*)(lds + PG8_SA(b, h) + aoff + m * 2048 + k * 1024); } } while (0)
#define PG8_LDB(dst, b, h) do { _Pragma("unroll") for (int n = 0; n < 2; ++n) _Pragma("unroll") for (int k = 0; k < 2; ++k) { if constexpr (FP8) { if (k == 0) dst##8[n] = PG8_CAT8(*(const PG8_LAS bf16x8*)(lds + PG8_SB(b, h) + boff + n * 2048), *(const PG8_LAS bf16x8*)(lds + PG8_SB(b, h) + boff + n * 2048 + 16)); } else dst[n][k] = *(const PG8_LAS bf16x8*)(lds + PG8_SB(b, h) + boff + n * 2048 + k * 1024); } } while (0)
#define PG8_MMA(ai, bj, At, Bt) do { __builtin_amdgcn_s_setprio(1); \
        if constexpr (FP8) { _Pragma("unroll") for (int m = 0; m < 4; ++m) _Pragma("unroll") for (int n = 0; n < 2; ++n) \
            asm volatile("v_mfma_scale_f32_16x16x128_f8f6f4 %0, %1, %2, %0, %3, %3 op_sel_hi:[0,0,0]" : "+v"(acc[ai][bj][m][n]) : "v"(Bt##8[n]), "v"(At##8[m]), "v"(fp8_unit_scale)); } \
        else { _Pragma("unroll") for (int m = 0; m < 4; ++m) _Pragma("unroll") for (int n = 0; n < 2; ++n) _Pragma("unroll") for (int k = 0; k < 2; ++k) \
            acc[ai][bj][m][n] = __builtin_amdgcn_mfma_f32_16x16x32_bf16(Bt[n][k], At[m][k], acc[ai][bj][m][n], 0, 0, 0); } \
        __builtin_amdgcn_s_setprio(0); } while (0)
#define PG8_WAIT_V(n) asm volatile("s_waitcnt vmcnt(" #n ")" ::: "memory")
#define PG8_WAIT_L(n) asm volatile("s_waitcnt lgkmcnt(" #n ")" ::: "memory")
#define PG8_BAR __builtin_amdgcn_s_barrier()
#define PG8_SCHED __builtin_amdgcn_sched_barrier(0)
    Unit cur, nxt; int ui = 0;
    if (!S.next(0, cur)) return;
    f32x4 acc[2][2][4][2];
#pragma unroll
    for (int a = 0; a < 2; ++a)
#pragma unroll
        for (int b = 0; b < 2; ++b)
#pragma unroll
            for (int m = 0; m < 4; ++m)
#pragma unroll
                for (int n = 0; n < 2; ++n) acc[a][b][m][n] = (f32x4){0.f, 0.f, 0.f, 0.f};
    bf16x8 At[4][2], B0[2][2], B1[2][2]; i32x8 At8[4], B08[2], B18[2];
    int fp8_unit_scale = 0x7F7F7F7F; asm volatile("" : "+v"(fp8_unit_scale));
    const char* cA = (const char*)g.A + (size_t)cur.pm * tstep; const char* cB = (const char*)g.Bt + (size_t)cur.pn * tstep;
    S.a_ready(cur);
    const char* const gA = (const char*)g.A;
    if constexpr (GATHER) { PG8_GOFF(offC, 0); }
    PG8_STAGE(PG8_SB(0, 0), cB, voffB);
    if constexpr (GATHER) PG8_STAGE_G(PG8_SA(0, 0), gA, offC[0]); else PG8_STAGE(PG8_SA(0, 0), cA, voffA);
    PG8_STAGE(PG8_SB(0, 1), cB + hstep, voffB);
    if constexpr (GATHER) PG8_STAGE_G(PG8_SA(0, 1), gA, offC[1]); else PG8_STAGE(PG8_SA(0, 1), cA + hstep, voffA);
    if (wr == 1) PG8_BAR;
    PG8_WAIT_V(4); PG8_BAR;
    PG8_STAGE(PG8_SB(1, 0), cB + kstep, voffB);
    if constexpr (GATHER) PG8_STAGE_G(PG8_SA(1, 0), gA + kstep, offC[0]); else PG8_STAGE(PG8_SA(1, 0), cA + kstep, voffA);
    PG8_STAGE(PG8_SB(1, 1), cB + hstep + kstep, voffB);
    PG8_WAIT_V(6); PG8_BAR;
    PG8_STAMP();
    for (;;) {
        const bool has_next = S.next(ui + 1, nxt);
        const char* nA = has_next ? (const char*)g.A + (size_t)nxt.pm * tstep : cA; const char* nB = has_next ? (const char*)g.Bt + (size_t)nxt.pn * tstep : cB;
        for (int t = 0; t < nt; t += 2) {
            const bool last = (t == nt - 2);
            const char* a1 = cA + (size_t)(t + 1) * kstep;
            const char* a2 = last ? nA : cA + (size_t)(t + 2) * kstep; const char* b2 = last ? nB : cB + (size_t)(t + 2) * kstep;
            const char* a3 = a2 + kstep; const char* b3 = b2 + kstep;
            if (last && has_next) S.a_ready(nxt);
            const char* const g1 = gA + (size_t)(t + 1) * kstep; const char* const g2 = last ? gA : gA + (size_t)(t + 2) * kstep; const char* const g3 = g2 + kstep;
            if constexpr (GATHER) { if (last) { if (has_next) { PG8_GOFF(offN, ui + 1); } else {
                _Pragma("unroll") for (int _h = 0; _h < 2; ++_h) _Pragma("unroll") for (int _i = 0; _i < 2; ++_i) offN[_h][_i] = offC[_h][_i]; } } }
            unsigned oS0[2], oS1[2];
            if constexpr (GATHER) { _Pragma("unroll") for (int _i = 0; _i < 2; ++_i) { oS0[_i] = last ? offN[0][_i] : offC[0][_i]; oS1[_i] = last ? offN[1][_i] : offC[1][_i]; } }
            PG8_LDB(B0, 0, 0); PG8_SCHED; PG8_LDA(At, 0, 0); if constexpr (GATHER) PG8_STAGE_G(PG8_SA(1, 1), g1, offC[1]); else PG8_STAGE(PG8_SA(1, 1), a1 + hstep, voffA);
            PG8_WAIT_L(8); PG8_BAR; PG8_WAIT_L(0); PG8_MMA(0, 0, At, B0); PG8_BAR; PG8_SCHED;
            PG8_LDB(B1, 0, 1); PG8_STAGE(PG8_SB(0, 0), b2, voffB);
            PG8_BAR; PG8_WAIT_L(0); PG8_MMA(0, 1, At, B1); PG8_BAR;
            PG8_LDA(At, 0, 1); if constexpr (GATHER) PG8_STAGE_G(PG8_SA(0, 0), g2, oS0); else PG8_STAGE(PG8_SA(0, 0), a2, voffA);
            PG8_BAR; PG8_WAIT_L(0); PG8_MMA(1, 0, At, B0); PG8_BAR; PG8_SCHED;
            PG8_STAGE(PG8_SB(0, 1), b2 + hstep, voffB);
            PG8_WAIT_V(6); PG8_BAR; PG8_MMA(1, 1, At, B1); PG8_BAR;
            PG8_LDB(B0, 1, 0); PG8_SCHED; PG8_LDA(At, 1, 0); if constexpr (GATHER) PG8_STAGE_G(PG8_SA(0, 1), g2, oS1); else PG8_STAGE(PG8_SA(0, 1), a2 + hstep, voffA);
            PG8_WAIT_L(8); PG8_BAR; PG8_WAIT_L(0); PG8_MMA(0, 0, At, B0); PG8_BAR; PG8_SCHED;
            PG8_LDB(B1, 1, 1); PG8_STAGE(PG8_SB(1, 0), b3, voffB);
            PG8_BAR; PG8_WAIT_L(0); PG8_MMA(0, 1, At, B1); PG8_BAR;
            PG8_LDA(At, 1, 1); if constexpr (GATHER) PG8_STAGE_G(PG8_SA(1, 0), g3, oS0); else PG8_STAGE(PG8_SA(1, 0), a3, voffA);
            PG8_BAR; PG8_WAIT_L(0); PG8_MMA(1, 0, At, B0); PG8_BAR; PG8_SCHED;
            PG8_STAGE(PG8_SB(1, 1), b3 + hstep, voffB);
            PG8_WAIT_V(6); PG8_BAR; PG8_MMA(1, 1, At, B1); PG8_BAR;
        }
        PG8_STAMP();
        if constexpr (FP8) asm volatile("s_nop 7\n\ts_nop 7\n\ts_nop 3" ::: "memory");
        if constexpr (!Epi::AFTER_DRAIN) { E(acc, cur, wr, wc, fr, fq); S.done(cur); }
        PG8_STAMP();
        if (!has_next) break;
#pragma unroll
        for (int a = 0; a < 2; ++a)
#pragma unroll
            for (int b = 0; b < 2; ++b)
#pragma unroll
                for (int m = 0; m < 4; ++m)
#pragma unroll
                    for (int n = 0; n < 2; ++n) acc[a][b][m][n] = (f32x4){0.f, 0.f, 0.f, 0.f};
        cur = nxt; cA = nA; cB = nB; ++ui;
        if constexpr (GATHER) { _Pragma("unroll") for (int _h = 0; _h < 2; ++_h) _Pragma("unroll") for (int _i = 0; _i < 2; ++_i) offC[_h][_i] = offN[_h][_i]; }
    }
    PG8_WAIT_V(0);
    if (wr == 0) PG8_BAR;
    PG8_BAR;
    if constexpr (Epi::AFTER_DRAIN) { E.fused(acc, cur, wr, wc, fr, fq, lds, wid, lane); S.done(cur); }
    PG8_STAMP();
    if (STAMP && wid == 0) { stamps[lane] = lane < nts ? (((unsigned long long)(unsigned)ts_hi << 32) | (unsigned)ts_lo) : 0ull;
        if (lane == 62) stamps[62] = rt_entry; if (lane == 63) stamps[63] = (unsigned long long)wall_clock64(); }
#undef PG8_STAMP
#undef PG8_SA
#undef PG8_SB
#undef PG8_STAGE
#undef PG8_STAGE_G
#undef PG8_GOFF
#undef PG8_LDA
#undef PG8_LDB
#undef PG8_MMA
#undef PG8_CAT8
#undef PG8_WAIT_V
#undef PG8_WAIT_L
#undef PG8_BAR
#undef PG8_SCHED
}
}
struct Ctx {
    LAS unsigned char* lds; int tid, lane, wave, G, bid;
    unsigned char* ws;
    DI Ctx fresh() const { Ctx c = *this; int lid = lane_id_fresh(); int wv = wave, b = bid, g = G; asm volatile("" : "+v"(lid), "+s"(wv), "+s"(b), "+s"(g));
        c.tid = wv * 64 + lid; c.lane = lid; c.wave = wv; c.bid = b; c.G = g; return c; }
    DI const float* in(int i) const { return (const float*)(const __attribute__((address_space(1))) float*)P()->in[i]; }
    DI float* out() const { return (float*)(__attribute__((address_space(1))) float*)P()->out; }
    DI unsigned char* wsp() const { return (unsigned char*)(__attribute__((address_space(1))) unsigned char*)P()->ws; }
    DI const __attribute__((address_space(4))) Params* P() const { return (const __attribute__((address_space(4))) Params*)__builtin_amdgcn_kernarg_segment_ptr(); }
    DI float* MOD() const { return (float*)(ws + WS_MOD); }
    DI float* RC() const { return (float*)(ws + WS_ROPE); }
    DI float* RS() const { return RC() + 4096; }
    DI float* MC() const { return RC() + 8192; }
    DI float* MS() const { return RC() + 8192 + 1024; }
    DI bf16_t* H16() const { return (bf16_t*)(ws + WS_H16); }
    DI bf16_t* U() const { return (bf16_t*)(ws + WS_U); }
    DI bf16_t* WMIX() const { return (bf16_t*)(ws + WS_WMIX); }
    DI bf16_t* W13() const { return (bf16_t*)(ws + WS_W13); }
    DI bf16_t* W2() const { return (bf16_t*)(ws + WS_W2); }
    DI unsigned char* S() const { return ws + WS_S; }
};

DI void phase_mod(const Ctx& F) {
    LAS float* act = (LAS float*)F.lds;
    LAS float* red = act + 17 * 1024;
    const float* c = F.in(1); const float* cctx = F.in(3); const float* ada_w = F.in(4); const float* ada_b = F.in(5);
    for (int i = F.tid; i < 17 * 1024; i += NTHREADS) { const int b = i >> 10, k = i & 1023; const float x = b < 16 ? c[b * 1024 + k] : cctx[k]; act[i] = x / (1.0f + expf(-x)); }
    __syncthreads();
    for (int unit = F.bid; unit < 4 * 96; unit += F.G) {
        const int l = unit / 96, n0 = (unit % 96) * 64;
        const float* W = ada_w + (size_t)l * 1024 * 6144 + n0 + F.lane;
        float a[17];
#pragma unroll
        for (int b = 0; b < 17; ++b) a[b] = 0.f;
        const int k0 = F.wave * 128;
#pragma unroll 1
        for (int kb = 0; kb < 128; kb += 16) { float w[16];
#pragma unroll
            for (int k = 0; k < 16; ++k) w[k] = W[(size_t)(k0 + kb + k) * 6144];
#pragma unroll
            for (int k = 0; k < 16; ++k)
#pragma unroll
                for (int b = 0; b < 17; ++b) a[b] += act[b * 1024 + k0 + kb + k] * w[k]; }
#pragma unroll
        for (int b = 0; b < 17; ++b) red[(F.wave * 17 + b) * 64 + F.lane] = a[b];
        __syncthreads();
        for (int i = F.tid; i < 17 * 64; i += NTHREADS) { const int b = i >> 6, n = i & 63; float s = ada_b[l * 6144 + n0 + n];
#pragma unroll
            for (int w = 0; w < 8; ++w) s += red[(w * 17 + b) * 64 + n];
            F.MOD()[((size_t)l * 17 + b) * 6144 + n0 + n] = s; }
        __syncthreads();
    }
}

DI void sincos_d(double a, double& s, double& c) {
    const double TWO_PI = 6.283185307179586476925286766559;
    const double n = rint(a / TWO_PI); const double r = a - n * TWO_PI;
    const double r2 = r * r; double ts = 1.0, tc = 1.0, ss = 1.0, cc = 1.0;
#pragma unroll
    for (int k = 1; k <= 16; ++k) { tc *= -r2 / (double)((2 * k - 1) * (2 * k)); cc += tc; ts *= -r2 / (double)((2 * k) * (2 * k + 1)); ss += ts; }
    s = r * ss; c = cc;
}
DI void phase_tables(const Ctx& F) {
    const int gt = F.bid * NTHREADS + F.tid, gs = F.G * NTHREADS;
    const double LN1E4 = 9.210340371976182736071965818737;
    for (int i = gt; i < 4096; i += gs) { const int p = i >> 6, f = i & 63; const double a = (double)p * exp(-LN1E4 * (double)f / 64.0); double s, c; sincos_d(a, s, c); F.RC()[i] = (float)c; F.RS()[i] = (float)s; }
    for (int i = gt; i < 1024; i += gs) { const int p = i >> 4, f = i & 15; const double a = (double)p * exp(-LN1E4 * (double)f / 16.0); double s, c; sincos_d(a, s, c); F.MC()[i] = (float)c; F.MS()[i] = (float)s; }
}

struct MapId   { const float* src; int ld; DI const float* col(int n0) const { return src + n0; } };
struct MapPad  { const float* src; int ld; int nvalid; DI const float* col(int n0) const { return n0 < nvalid ? src + n0 : nullptr; } };
struct MapConvIn { const float* src; int ld; DI const float* col(int n0) const { if (n0 < 1024) return src + n0; const int q = n0 - 1024, p = q >> 8, half = (q >> 7) & 1, i = q & 127; return src + 1024 + half * 1024 + p * 128 + i; } };
struct MapW13  { const float* w1; const float* w3; int ld; DI const float* col(int n0) const { const int e = n0 >> 10, nn = n0 & 1023, p = nn >> 8, half = (nn >> 7) & 1, i = nn & 127; return w1 + (ptrdiff_t)half * (w3 - w1) + (size_t)e * 1024 * 512 + p * 128 + i; } };
struct MapW2   { const float* w2; int ld; DI const float* col(int n0) const { const int e = n0 >> 10, nn = n0 & 1023; return w2 + (size_t)e * 512 * 1024 + nn; } };
template <bool FP8, class Map> DI void wconv_job2(const Ctx& F, const Map& mp, int K, int Ndst, unsigned char* dst, float wscale = 1.0f) {
    constexpr int KT = FP8 ? 128 : 64, NTL = FP8 ? 128 : 256, P1 = NTL + 4, TPR = NTL / 4, RPP = NTHREADS / TPR, ES = FP8 ? 1 : 2, NW = FP8 ? 2 : 4;
    LAS float* tile = (LAS float*)F.lds; LAS unsigned char* st2 = F.lds + KT * P1 * 4;
    const int ntk = K / KT, nt = (Ndst / NTL) * ntk;
    const int n4 = (F.tid % TPR) * 4, kr = F.tid / TPR, an = F.tid % NTL, akq = F.tid / NTL;
    const size_t rowb = (size_t)K * ES;
    f32x4 v[8];
#define WC_LOADS(t_) do { const int tn_ = (t_) / ntk, tk_ = (t_) - tn_ * ntk; const float* src_ = mp.col(tn_ * NTL + (n4 & ~63)); \
        _Pragma("unroll") for (int it = 0; it < 8; ++it) v[it] = src_ ? *(const f32x4*)(src_ + (size_t)(tk_ * KT + it * RPP + kr) * mp.ld + (n4 & 63)) : (f32x4){0.f, 0.f, 0.f, 0.f}; } while (0)
    int t = F.bid;
    if (t < nt) WC_LOADS(t);
    for (; t < nt; t += F.G) {
        const int tn = t / ntk, tk = t - tn * ntk, n0 = tn * NTL, k0 = tk * KT;
#pragma unroll
        for (int it = 0; it < 8; ++it) *(LAS f32x4*)(tile + (it * RPP + kr) * P1 + n4) = v[it];
        __syncthreads();
        if (t + F.G < nt) WC_LOADS(t + F.G);
        {   const LAS float* tp = tile + (akq * 32) * P1 + an; u32x4 w[NW];
            if constexpr (FP8) {
#pragma unroll
                for (int q = 0; q < 8; ++q) { f32x4 a; a[0] = tp[(4 * q) * P1] * FP8_SW; a[1] = tp[(4 * q + 1) * P1] * FP8_SW; a[2] = tp[(4 * q + 2) * P1] * FP8_SW; a[3] = tp[(4 * q + 3) * P1] * FP8_SW; w[q >> 2][q & 3] = pack_fp8x4(clamp_fp8(a)); }
            } else {
#pragma unroll
                for (int q = 0; q < 16; ++q) w[q >> 2][q & 3] = cvt_pk_bf16(tp[(2 * q) * P1] * wscale, tp[(2 * q + 1) * P1] * wscale);
            }
#pragma unroll
            for (int i = 0; i < NW; ++i) *(LAS u32x4*)(st2 + an * 144 + akq * (32 * ES) + i * 16) = w[i];
        }
        __syncthreads();
#pragma unroll
        for (int it = 0; it < NTL / 64; ++it) { const int row = it * 64 + (F.tid >> 3), ch = F.tid & 7;
            *(u32x4*)(dst + (size_t)(n0 + row) * rowb + (size_t)k0 * ES + ch * 16) = *(const LAS u32x4*)(st2 + row * 144 + ch * 16); }
    }
#undef WC_LOADS
    __syncthreads();
}
template <class Map> DI void wconv_job(const Ctx& F, const Map& mp, int K, int Ndst, bf16_t* dst, float wscale = 1.0f) { wconv_job2<false>(F, mp, K, Ndst, (unsigned char*)dst, wscale); }
template <class Map> DI void wconv_job_fp8(const Ctx& F, const Map& mp, int K, int Ndst, unsigned char* dst) { wconv_job2<true>(F, mp, K, Ndst, dst); }
constexpr size_t WM_RET_IN = 0, WM_RET_OUT = (size_t)6144 * 1024;
constexpr size_t WM_MLA_DOWN = 0, WM_MLA_UQ = (size_t)768 * 1024, WM_MLA_UKV = WM_MLA_UQ + (size_t)1536 * 384, WM_MLA_OUT = WM_MLA_UKV + (size_t)2048 * 256;
constexpr size_t WM_CONV_IN = 0, WM_CONV_OUT = (size_t)3072 * 1024;
DI void phase_wconv(const Ctx& F, int l) {
    const int kind = l % 3, j = l / 3;
    if (kind == 0) {
        wconv_job(F, MapId{F.in(8) + (size_t)j * 1024 * 6144, 6144}, 1024, 6144, F.WMIX() + WM_RET_IN);
        wconv_job(F, MapId{F.in(11) + (size_t)j * 2048 * 1024, 1024}, 2048, 1024, F.WMIX() + WM_RET_OUT);
    } else if (kind == 1) {
        wconv_job(F, MapPad{F.in(12), 704, 704}, 1024, 768, F.WMIX() + WM_MLA_DOWN);
        wconv_job(F, MapId{F.in(15), 1536}, 384, 1536, F.WMIX() + WM_MLA_UQ, 0.07216878364870322f * 1.4426950408889634f);
        wconv_job(F, MapId{F.in(16), 2048}, 256, 2048, F.WMIX() + WM_MLA_UKV);
        wconv_job(F, MapId{F.in(17), 1024}, 1024, 1024, F.WMIX() + WM_MLA_OUT);
    } else {
        wconv_job(F, MapConvIn{F.in(18), 3072}, 1024, 3072, F.WMIX() + WM_CONV_IN);
        wconv_job(F, MapId{F.in(21), 1024}, 1024, 1024, F.WMIX() + WM_CONV_OUT);
    }
    wconv_job_fp8(F, MapW13{F.in(26) + (size_t)l * 32 * 1024 * 512, F.in(27) + (size_t)l * 32 * 1024 * 512, 512}, 1024, 32 * 1024, (unsigned char*)F.W13());
    wconv_job_fp8(F, MapW2{F.in(28) + (size_t)l * 32 * 512 * 1024, 1024}, 512, 32 * 1024, (unsigned char*)F.W2());
}

DI const float* xrow(const Ctx& F, int row) { return row < NCTX ? F.in(2) + (size_t)row * DM : F.in(0) + (size_t)(row - NCTX) * DM; }
DI int row_bp(int row) { return row < NCTX ? 16 : ((row - NCTX) >> 12); }

DI void phase_u0(const Ctx& F) {
    const float* mod0 = F.MOD();
    const int c0 = (F.tid & 127) * 8;
#define U0_LOAD(H0, H1, rb_) do { _Pragma("unroll") for (int j = 0; j < 4; ++j) { const int row = (rb_) + j * F.G * 4; if (row < NTOK) { const float* h = xrow(F, row) + c0; H0[j] = *(const f32x4*)h; H1[j] = *(const f32x4*)(h + 4); } } } while (0)
#define U0_PROC(H0, H1, rb_) do { _Pragma("unroll") for (int j = 0; j < 4; ++j) { const int row = (rb_) + j * F.G * 4; if (row < NTOK) { const float* m = mod0 + (size_t)row_bp(row) * 6144 + c0; \
            const f32x4 sh0 = *(const f32x4*)m, sh1 = *(const f32x4*)(m + 4), sc0 = *(const f32x4*)(m + 1024), sc1 = *(const f32x4*)(m + 1028); \
            *(u32x4*)(F.U() + (size_t)row * DM + c0) = pack8(H0[j] * (sc0 + 1.0f) + sh0, H1[j] * (sc1 + 1.0f) + sh1); \
            const u32x2 a = pack_h4(H0[j]), b = pack_h4(H1[j]); u32x4 w; w.x = a.x; w.y = a.y; w.z = b.x; w.w = b.y; *(u32x4*)(F.H16() + (size_t)row * DM + c0) = w; } } } while (0)
    f32x4 a0[4], a1[4], b0[4], b1[4];
    const int step = F.G * 16;
    int rb = F.bid * 4 + (F.tid >> 7);
    U0_LOAD(a0, a1, rb);
    for (; rb < NTOK; rb += 2 * step) {
        U0_LOAD(b0, b1, rb + step);
        U0_PROC(a0, a1, rb);
        U0_LOAD(a0, a1, rb + 2 * step);
        U0_PROC(b0, b1, rb + step);
    }
#undef U0_LOAD
#undef U0_PROC
}

constexpr int RT_VT = 0;
constexpr int RT_VSTRIDE = 1032;
constexpr int RT_RED = RT_VT + 16 * RT_VSTRIDE * 2;
constexpr int RT_LG = RT_RED + 8 * 16 * 48 * 4;
constexpr int RT_HIST = RT_LG + 16 * 36 * 4, RT_BASE = RT_HIST + 128, RT_INFO = RT_BASE + 128, RT_VEC = RT_INFO + 544 * 4, RT_END = RT_VEC + 5 * 4096;
static_assert(RT_END <= XB_LDS_OFF - 16, "router LDS");
constexpr int ROWS_PER_BLOCK = NTOK / 256;
static_assert(ROWS_PER_BLOCK * 256 == NTOK && ROWS_PER_BLOCK % 16 == 0, "row split");
DI void phase_ln1_router(const Ctx& F, int l, const bf16_t* Y, int r0, int rpb) {
    LAS _Float16* Vt = (LAS _Float16*)(F.lds + RT_VT); LAS float* red = (LAS float*)(F.lds + RT_RED); LAS float* lgs = (LAS float*)(F.lds + RT_LG);
    LAS unsigned* hist = (LAS unsigned*)(F.lds + RT_HIST); LAS unsigned* base = (LAS unsigned*)(F.lds + RT_BASE); LAS unsigned* rinfo = (LAS unsigned*)(F.lds + RT_INFO);
    const float* wg = F.in(22) + (size_t)l * 1024 * 4; const float* bg = F.in(23) + l * 4; const float* we = F.in(24) + (size_t)l * 1024 * 32; const float* be = F.in(25) + l * 32;
    if (F.tid < 32) hist[F.tid] = 0u;
    typedef _Float16 h16x8 __attribute__((ext_vector_type(8)));
    h16x8 wreg[4][3];
    {   const int col = F.lane & 15, kq = F.lane >> 4;
#pragma unroll
        for (int s = 0; s < 4; ++s)
#pragma unroll
            for (int ct = 0; ct < 3; ++ct) { const int e = 16 * ct + col;
#pragma unroll
                for (int jj = 0; jj < 8; ++jj) { const int k = F.wave * 128 + 32 * s + 8 * kq + jj; wreg[s][ct][jj] = (_Float16)(e < 4 ? wg[k * 4 + e] : (e < 36 ? we[k * 32 + (e - 4)] : 0.f)); } } }
    const float* lng = F.in(6) + (size_t)(l * 2 + 0) * DM; const float* lnb = F.in(7) + (size_t)(l * 2 + 0) * DM;
    const float* modl = F.MOD() + (size_t)l * 17 * 6144;
    int* slot_e = (int*)(F.ws + WS_SLOTE); int* slot_r = (int*)(F.ws + WS_SLOTR); float* slot_w = (float*)(F.ws + WS_SLOTW);
    unsigned* gcount = (unsigned*)(F.ws + WS_CTL + CTL_GCOUNT) + l * 32;
    const int rblk = r0 + F.bid * rpb;
    LAS float* vec = (LAS float*)(F.lds + RT_VEC);
    int bp_cur = row_bp(rblk);
    for (int i = F.tid; i < 1024; i += NTHREADS) { vec[i] = lng[i]; vec[1024 + i] = lnb[i]; const float* m = modl + (size_t)bp_cur * 6144; vec[2048 + i] = m[2 * 1024 + i]; vec[3072 + i] = m[3 * 1024 + i]; vec[4096 + i] = m[4 * 1024 + i]; }
    u32x2 zpre[2][4], ypre[2][4];
#pragma unroll
    for (int rr = 0; rr < 2; ++rr) { const int row = rblk + F.wave * 2 + rr; const bf16_t* hp = F.H16() + (size_t)row * DM + F.lane * 4; const bf16_t* yp = Y + (size_t)row * DM + F.lane * 4;
#pragma unroll
        for (int j = 0; j < 4; ++j) { zpre[rr][j] = *(const u32x2*)(hp + 256 * j); ypre[rr][j] = *(const u32x2*)(yp + 256 * j); } }
    __syncthreads();
#pragma unroll 1
    for (int grp = 0; grp < rpb / 16; ++grp) {
        {   const int bpg = row_bp(rblk + grp * 16);
            if (bpg != bp_cur) {
                bp_cur = bpg; __syncthreads();
                for (int i = F.tid; i < 1024; i += NTHREADS) { const float* m = modl + (size_t)bp_cur * 6144; vec[2048 + i] = m[2 * 1024 + i]; vec[3072 + i] = m[3 * 1024 + i]; vec[4096 + i] = m[4 * 1024 + i]; }
                __syncthreads();
            }
            f32x4 z[2][4]; float s[2] = {0.f, 0.f};
#pragma unroll
            for (int rr = 0; rr < 2; ++rr)
#pragma unroll
                for (int j = 0; j < 4; ++j) { const f32x4 gt = *(const LAS f32x4*)(vec + 2048 + F.lane * 4 + 256 * j); const u32x2 yw = ypre[rr][j];
                    f32x4 y; y[0] = bflo(yw.x); y[1] = bfhi(yw.x); y[2] = bflo(yw.y); y[3] = bfhi(yw.y);
                    const f32x4 hh = unpack_h4(zpre[rr][j]);
                    z[rr][j] = hh * ALPHA + gt * y; s[rr] += (z[rr][j][0] + z[rr][j][1]) + (z[rr][j][2] + z[rr][j][3]); }
            if (grp + 1 < rpb / 16) {
#pragma unroll
                for (int rr = 0; rr < 2; ++rr) { const int row = rblk + (grp + 1) * 16 + F.wave * 2 + rr; const bf16_t* hp = F.H16() + (size_t)row * DM + F.lane * 4; const bf16_t* yp = Y + (size_t)row * DM + F.lane * 4;
#pragma unroll
                    for (int j = 0; j < 4; ++j) { zpre[rr][j] = *(const u32x2*)(hp + 256 * j); ypre[rr][j] = *(const u32x2*)(yp + 256 * j); } }
            }
#pragma unroll
            for (int m = 32; m >= 1; m >>= 1) { s[0] += __shfl_xor(s[0], m, 64); s[1] += __shfl_xor(s[1], m, 64); }
            float s2[2] = {0.f, 0.f};
#pragma unroll
            for (int rr = 0; rr < 2; ++rr) { const float mean = s[rr] * (1.0f / 1024.0f);
#pragma unroll
                for (int j = 0; j < 4; ++j) { z[rr][j] -= mean; s2[rr] += (z[rr][j][0] * z[rr][j][0] + z[rr][j][1] * z[rr][j][1]) + (z[rr][j][2] * z[rr][j][2] + z[rr][j][3] * z[rr][j][3]); } }
#pragma unroll
            for (int m = 32; m >= 1; m >>= 1) { s2[0] += __shfl_xor(s2[0], m, 64); s2[1] += __shfl_xor(s2[1], m, 64); }
#pragma unroll
            for (int rr = 0; rr < 2; ++rr) {
                const int rg = F.wave * 2 + rr, row = rblk + grp * 16 + rg; const float rstd = rsqrtf(s2[rr] * (1.0f / 1024.0f) + LN_EPS);
                bf16_t* hp = F.H16() + (size_t)row * DM + F.lane * 4;
#pragma unroll
                for (int j = 0; j < 4; ++j) { const int c = F.lane * 4 + 256 * j;
                    const f32x4 h = z[rr][j] * rstd * *(const LAS f32x4*)(vec + c) + *(const LAS f32x4*)(vec + 1024 + c);
                    *(u32x2*)(hp + 256 * j) = pack_h4(h);
                    const f32x4 sh = *(const LAS f32x4*)(vec + 3072 + c), sc = *(const LAS f32x4*)(vec + 4096 + c); const f32x4 v = h * (sc + 1.0f) + sh;
                    *(unsigned*)((unsigned char*)F.U() + (size_t)row * DM + c) = pack_fp8x4(clamp_fp8(v * FP8_SU));
                    *(LAS u32x2*)(Vt + rg * RT_VSTRIDE + c) = pack_h4(v); }
            }
        }
        __syncthreads();
        {   f32x4 acc[3];
#pragma unroll
            for (int ct = 0; ct < 3; ++ct) acc[ct] = (f32x4){0.f, 0.f, 0.f, 0.f};
            const LAS _Float16* ap = Vt + (F.lane & 15) * RT_VSTRIDE + F.wave * 128 + 8 * (F.lane >> 4);
#pragma unroll
            for (int s = 0; s < 4; ++s) { const h16x8 a = *(const LAS h16x8*)(ap + 32 * s);
#pragma unroll
                for (int ct = 0; ct < 3; ++ct) acc[ct] = __builtin_amdgcn_mfma_f32_16x16x32_f16(a, wreg[s][ct], acc[ct], 0, 0, 0); }
#pragma unroll
            for (int ct = 0; ct < 3; ++ct)
#pragma unroll
                for (int r = 0; r < 4; ++r) red[(F.wave * 16 + 4 * (F.lane >> 4) + r) * 48 + 16 * ct + (F.lane & 15)] = acc[ct][r];
        }
        __syncthreads();
        for (int i = F.tid; i < 16 * 36; i += NTHREADS) { const int r = i / 36, e = i - r * 36; float s = e < 4 ? bg[e] : be[e - 4];
#pragma unroll
            for (int w = 0; w < 8; ++w) s += red[(w * 16 + r) * 48 + e];
            lgs[i] = s; }
        __syncthreads();
        if (F.tid < 16) {
            const int rg = F.tid, row = rblk + grp * 16 + rg; const LAS float* lg = lgs + rg * 36;
            int gi = 0; float gm = lg[0];
            for (int g = 1; g < 4; ++g) if (lg[g] > gm) { gm = lg[g]; gi = g; }
            float gden = 0.f;
            for (int g = 0; g < 4; ++g) gden += expf(lg[g] - gm);
            const float gp = 1.0f / gden;
            const LAS float* el = lg + 4 + gi * 8;
            int e0 = 0; float m0 = el[0];
            for (int q = 1; q < 8; ++q) if (el[q] > m0) { m0 = el[q]; e0 = q; }
            int e1 = -1; float m1 = -3.0e38f;
            for (int q = 0; q < 8; ++q) if (q != e0 && el[q] > m1) { m1 = el[q]; e1 = q; }
            const float t = expf(m1 - m0); const float w0 = gp / (1.0f + t), w1 = gp * t / (1.0f + t);
            const int ex0 = gi * 8 + e0, ex1 = gi * 8 + e1, rl = grp * 16 + rg;
            const unsigned r0 = atomicAdd((unsigned*)&hist[ex0], 1u); const unsigned r1 = atomicAdd((unsigned*)&hist[ex1], 1u);
            rinfo[rl * 2 + 0] = ((unsigned)ex0 << 24) | r0; rinfo[rl * 2 + 1] = ((unsigned)ex1 << 24) | r1;
            slot_w[(size_t)row * 2 + 0] = w0; slot_w[(size_t)row * 2 + 1] = w1;
        }
    }
    __syncthreads();
    if (F.tid < 32) base[F.tid] = atomicAdd(&gcount[F.tid], hist[F.tid]);
    __syncthreads();
    for (int i = F.tid; i < rpb * 2; i += NTHREADS) { const unsigned ri = rinfo[i]; const int e = (int)(ri >> 24); slot_e[(size_t)rblk * 2 + i] = e; slot_r[(size_t)rblk * 2 + i] = (int)(base[e] + (ri & 0xffffffu)); }
    __syncthreads();
}

DI void moe_prefix(const Ctx& F, int l, LAS int* ps  , LAS int* cnt  ) {
    const unsigned* gcount = (const unsigned*)(F.ws + WS_CTL + CTL_GCOUNT) + l * 32;
    if (F.tid < 64) {
        const int L = F.tid; const int c = L < 32 ? (int)__hip_atomic_load(&gcount[L & 31], __ATOMIC_RELAXED, __HIP_MEMORY_SCOPE_AGENT) : 0;
        const int pad = (c + 255) / 256 * 256; int inc = pad;
#pragma unroll
        for (int d = 1; d < 32; d <<= 1) { const int v = __shfl_up(inc, d, 64); if (L >= d) inc += v; }
        if (L < 32) { cnt[L] = c; ps[L] = inc - pad; if (L == 31) ps[32] = inc; }
    }
    __syncthreads();
}
DI void phase_moe_pos(const Ctx& F, int l, int r0) {
    LAS int* ps = (LAS int*)F.lds; LAS int* cnt = ps + 64;
    moe_prefix(F, l, ps, cnt);
    const int* slot_e = (const int*)(F.ws + WS_SLOTE); const int* slot_r = (const int*)(F.ws + WS_SLOTR); const float* slot_w = (const float*)(F.ws + WS_SLOTW);
    int* rowtok = (int*)(F.ws + WS_ROWTOK); float* roww = (float*)(F.ws + WS_ROWW);
    if (F.bid < 32) { const int e = F.bid; const int pe = (cnt[e] + 255) / 256 * 256; for (int i = cnt[e] + F.tid; i < pe; i += NTHREADS) rowtok[ps[e] + i] = -1; }
    for (int sl = 2 * r0 + F.bid * NTHREADS + F.tid; sl < NSLOT; sl += F.G * NTHREADS) { const int dest = ps[slot_e[sl]] + slot_r[sl]; rowtok[dest] = sl; roww[dest] = slot_w[sl]; }
}

DI void phase_ln2(const Ctx& F, int l, int r0, int rpb) {
    LAS float* vec = (LAS float*)F.lds;
    const float* lng = F.in(6) + (size_t)(l * 2 + 1) * DM; const float* lnb = F.in(7) + (size_t)(l * 2 + 1) * DM;
    const float* modl = F.MOD() + (size_t)l * 17 * 6144; const float* modn = F.MOD() + (size_t)(l + 1 < DEPTH ? l + 1 : l) * 17 * 6144;
    const unsigned char* YS = (const unsigned char*)(F.S() + S_YS);
    const bool has_next = (l + 1 < DEPTH);
    const int rblk = r0 + F.bid * rpb;
    int bp_cur = row_bp(rblk);
    for (int i = F.tid; i < 1024; i += NTHREADS) { vec[i] = lng[i]; vec[1024 + i] = lnb[i]; vec[2048 + i] = modl[(size_t)bp_cur * 6144 + 5 * 1024 + i]; vec[3072 + i] = modn[(size_t)bp_cur * 6144 + i]; vec[4096 + i] = modn[(size_t)bp_cur * 6144 + 1024 + i]; }
    u32x2 hpre[2][4]; unsigned y0p[2][4], y1p[2][4];
#define LN2_LOAD(grp_) do { _Pragma("unroll") for (int rr = 0; rr < 2; ++rr) { const int row = rblk + (grp_) * 16 + F.wave * 2 + rr; const bf16_t* hp = F.H16() + (size_t)row * DM + F.lane * 4; const unsigned char* y0 = YS + (size_t)row * 2 * DM + F.lane * 4; \
        _Pragma("unroll") for (int j = 0; j < 4; ++j) { hpre[rr][j] = *(const u32x2*)(hp + 256 * j); y0p[rr][j] = *(const unsigned*)(y0 + 256 * j); y1p[rr][j] = *(const unsigned*)(y0 + DM + 256 * j); } } } while (0)
    LN2_LOAD(0);
    __syncthreads();
#pragma unroll 1
    for (int grp = 0; grp < rpb / 16; ++grp) {
        const int bpg = row_bp(rblk + grp * 16);
        if (bpg != bp_cur) { bp_cur = bpg; __syncthreads();
            for (int i = F.tid; i < 1024; i += NTHREADS) { vec[2048 + i] = modl[(size_t)bp_cur * 6144 + 5 * 1024 + i]; vec[3072 + i] = modn[(size_t)bp_cur * 6144 + i]; vec[4096 + i] = modn[(size_t)bp_cur * 6144 + 1024 + i]; }
            __syncthreads(); }
        f32x4 z[2][4]; float s[2] = {0.f, 0.f};
#pragma unroll
        for (int rr = 0; rr < 2; ++rr)
#pragma unroll
            for (int j = 0; j < 4; ++j) { const f32x4 gt = *(const LAS f32x4*)(vec + 2048 + F.lane * 4 + 256 * j); const int a = (int)y0p[rr][j], b = (int)y1p[rr][j];
                f32x4 f; f[0] = __builtin_amdgcn_cvt_f32_fp8(a, 0) + __builtin_amdgcn_cvt_f32_fp8(b, 0); f[1] = __builtin_amdgcn_cvt_f32_fp8(a, 1) + __builtin_amdgcn_cvt_f32_fp8(b, 1);
                f[2] = __builtin_amdgcn_cvt_f32_fp8(a, 2) + __builtin_amdgcn_cvt_f32_fp8(b, 2); f[3] = __builtin_amdgcn_cvt_f32_fp8(a, 3) + __builtin_amdgcn_cvt_f32_fp8(b, 3); f *= (1.0f / 64.0f);
                const f32x4 hh = unpack_h4(hpre[rr][j]);
                z[rr][j] = hh * ALPHA + gt * f; s[rr] += (z[rr][j][0] + z[rr][j][1]) + (z[rr][j][2] + z[rr][j][3]); }
        if (grp + 1 < rpb / 16) LN2_LOAD(grp + 1);
#pragma unroll
        for (int m = 32; m >= 1; m >>= 1) { s[0] += __shfl_xor(s[0], m, 64); s[1] += __shfl_xor(s[1], m, 64); }
        float s2[2] = {0.f, 0.f};
#pragma unroll
        for (int rr = 0; rr < 2; ++rr) { const float mean = s[rr] * (1.0f / 1024.0f);
#pragma unroll
            for (int j = 0; j < 4; ++j) { z[rr][j] -= mean; s2[rr] += (z[rr][j][0] * z[rr][j][0] + z[rr][j][1] * z[rr][j][1]) + (z[rr][j][2] * z[rr][j][2] + z[rr][j][3] * z[rr][j][3]); } }
#pragma unroll
        for (int m = 32; m >= 1; m >>= 1) { s2[0] += __shfl_xor(s2[0], m, 64); s2[1] += __shfl_xor(s2[1], m, 64); }
#pragma unroll
        for (int rr = 0; rr < 2; ++rr) {
            const int row = rblk + grp * 16 + F.wave * 2 + rr; const float rstd = rsqrtf(s2[rr] * (1.0f / 1024.0f) + LN_EPS);
#pragma unroll
            for (int j = 0; j < 4; ++j) { const int c = F.lane * 4 + 256 * j;
                const f32x4 h = z[rr][j] * rstd * *(const LAS f32x4*)(vec + c) + *(const LAS f32x4*)(vec + 1024 + c);
                if (!has_next) { *(f32x4*)(F.out() + (size_t)(row - NCTX) * DM + c) = h; }
                else *(u32x2*)(F.H16() + (size_t)row * DM + c) = pack_h4(h);
                if (has_next) { const f32x4 sh = *(const LAS f32x4*)(vec + 3072 + c), sc = *(const LAS f32x4*)(vec + 4096 + c); const f32x4 v = h * (sc + 1.0f) + sh;
                    u32x2 w; w.x = cvt_pk_bf16(v[0], v[1]); w.y = cvt_pk_bf16(v[2], v[3]); *(u32x2*)(F.U() + (size_t)row * DM + c) = w; } }
        }
    }
#undef LN2_LOAD
    __syncthreads();
}

DI void mla_prep_row(const Ctx& F, int row, const u32x4& c0, const u32x4& c1) {
    bf16_t* DQ = (bf16_t*)(F.S() + S_DQ); bf16_t* DKV = (bf16_t*)(F.S() + S_DKV); bf16_t* KK = (bf16_t*)(F.S() + S_KK);
    const float* qn = F.in(13); const float* kn = F.in(14); const int L = F.lane;
    float a[8], b[8];
    a[0] = bflo(c0.x); a[1] = bfhi(c0.x); a[2] = bflo(c0.y); a[3] = bfhi(c0.y); a[4] = bflo(c0.z); a[5] = bfhi(c0.z); a[6] = bflo(c0.w); a[7] = bfhi(c0.w);
    b[0] = bflo(c1.x); b[1] = bfhi(c1.x); b[2] = bflo(c1.y); b[3] = bfhi(c1.y); b[4] = bflo(c1.z); b[5] = bfhi(c1.z); b[6] = bflo(c1.w); b[7] = bfhi(c1.w);
    float sa = 0.f, sb = 0.f;
#pragma unroll
    for (int j = 0; j < 8; ++j) { sa += a[j] * a[j]; sb += b[j] * b[j]; }
    float sq = (L < 48) ? sa : 0.f, sk = ((L >= 48) ? sa : 0.f) + ((L < 16) ? sb : 0.f);
#pragma unroll
    for (int m = 32; m >= 1; m >>= 1) { sq += __shfl_xor(sq, m, 64); sk += __shfl_xor(sk, m, 64); }
    const float rq = rsqrtf(sq * (1.0f / 384.0f) + RMS_EPS), rk = rsqrtf(sk * (1.0f / 256.0f) + RMS_EPS);
    {   const float* gp = (L < 48) ? (qn + 8 * L) : (kn + 8 * (L - 48)); const float r = (L < 48) ? rq : rk;
        const f32x4 g0 = *(const f32x4*)gp, g1 = *(const f32x4*)(gp + 4);
        f32x4 o0, o1; o0[0] = a[0] * r * g0[0]; o0[1] = a[1] * r * g0[1]; o0[2] = a[2] * r * g0[2]; o0[3] = a[3] * r * g0[3]; o1[0] = a[4] * r * g1[0]; o1[1] = a[5] * r * g1[1]; o1[2] = a[6] * r * g1[2]; o1[3] = a[7] * r * g1[3];
        bf16_t* dst = (L < 48) ? (DQ + (size_t)row * 384 + 8 * L) : (DKV + (size_t)row * 256 + 8 * (L - 48));
        *(u32x4*)dst = pack8(o0, o1); }
    if (L < 16) { const float* gp = kn + 8 * (L + 16); const f32x4 g0 = *(const f32x4*)gp, g1 = *(const f32x4*)(gp + 4);
        f32x4 o0, o1; o0[0] = b[0] * rk * g0[0]; o0[1] = b[1] * rk * g0[1]; o0[2] = b[2] * rk * g0[2]; o0[3] = b[3] * rk * g0[3]; o1[0] = b[4] * rk * g1[0]; o1[1] = b[5] * rk * g1[1]; o1[2] = b[6] * rk * g1[2]; o1[3] = b[7] * rk * g1[3];
        *(u32x4*)(DKV + (size_t)row * 256 + 8 * (L + 16)) = pack8(o0, o1); }
    float pr[8];
#pragma unroll
    for (int j = 0; j < 8; ++j) pr[j] = __shfl_xor(b[j], 4, 64);
    if (L >= 16 && L < 24) {
        const int m = L - 16; int bb, pos; f32x4 o0, o1;
        if (row >= NCTX) { const int rr = row - NCTX; bb = rr >> 12; const int t = rr & 4095; pos = CTXL + t;
            const int i0 = (m & 3) * 8;
            const int p = (i0 < 16) ? (t >> 6) : (t & 63); const float* cp = F.MC() + p * 16 + (i0 & 15); const float* sp = F.MS() + p * 16 + (i0 & 15);
            const f32x4 ca = *(const f32x4*)cp, cb = *(const f32x4*)(cp + 4), sa4 = *(const f32x4*)sp, sb4 = *(const f32x4*)(sp + 4);
#pragma unroll
            for (int j = 0; j < 8; ++j) { const float c = j < 4 ? ca[j & 3] : cb[j & 3], s = j < 4 ? sa4[j & 3] : sb4[j & 3];
                const float v = (m < 4) ? (b[j] * c - pr[j] * s) : (pr[j] * s + b[j] * c);
                if (j < 4) o0[j & 3] = v; else o1[j & 3] = v; }
        } else { bb = row >> 8; pos = row & 255;
#pragma unroll
            for (int j = 0; j < 8; ++j) { if (j < 4) o0[j & 3] = b[j]; else o1[j & 3] = b[j]; } }
        const u32x4 w = pack8(o0, o1);
#pragma unroll
        for (int h = 0; h < 8; ++h) *(u32x4*)(KK + ((size_t)(bb * 8 + h) * KVLEN + pos) * 192 + 128 + 8 * m) = w;
    }
}
DI void phase_mla_prep(const Ctx& F) {
    const bf16_t* DWN = (const bf16_t*)(F.S() + S_DWN);
    const int L = F.lane, L2 = (L < 24) ? (64 + L) : L;
    for (int row = F.bid * 8 + F.wave; row < NTOK; row += F.G * 16) {
        const int row2 = row + F.G * 8;
        const u32x4 a0 = *(const u32x4*)(DWN + (size_t)row * 768 + 8 * L), a1 = *(const u32x4*)(DWN + (size_t)row * 768 + 8 * L2);
        u32x4 b0 = a0, b1 = a1;
        if (row2 < NTOK) { b0 = *(const u32x4*)(DWN + (size_t)row2 * 768 + 8 * L); b1 = *(const u32x4*)(DWN + (size_t)row2 * 768 + 8 * L2); }
        mla_prep_row(F, row, a0, a1);
        if (row2 < NTOK) mla_prep_row(F, row2, b0, b1);
    }
}

DI void phase_stats_fin(const Ctx& F) {
    const float* ST = (const float*)(F.ws + WS_STATS); float* MR = (float*)(F.ws + WS_MR);
    for (int i = F.bid * NTHREADS + F.tid; i < NTOK * 4; i += F.G * NTHREADS) {
        const f32x4 a0 = *(const f32x4*)(ST + (size_t)i * 16), a1 = *(const f32x4*)(ST + (size_t)i * 16 + 4), a2 = *(const f32x4*)(ST + (size_t)i * 16 + 8), a3 = *(const f32x4*)(ST + (size_t)i * 16 + 12);
        const float s = (a0[0] + a0[2]) + (a1[0] + a1[2]) + (a2[0] + a2[2]) + (a3[0] + a3[2]);
        const float ss = (a0[1] + a0[3]) + (a1[1] + a1[3]) + (a2[1] + a2[3]) + (a3[1] + a3[3]);
        const float mean = s * (1.0f / 512.0f); float var = ss * (1.0f / 512.0f) - mean * mean; var = var > 0.f ? var : 0.f;
        *(f32x2*)(MR + (size_t)i * 2) = (f32x2){mean, rsqrtf(var + LN_EPS)};
    }
}

DI void conv8(f32x4& ra, f32x4& rb, const u32x4& pm, const u32x4& pc, const u32x4& pp, const u32x4& gb, const f32x4 (&w)[6], const f32x4& ba, const f32x4& bb) {
    ra[0] = bflo(gb.x) * (bflo(pm.x) * w[0][0] + bflo(pc.x) * w[2][0] + bflo(pp.x) * w[4][0] + ba[0]);
    ra[1] = bfhi(gb.x) * (bfhi(pm.x) * w[0][1] + bfhi(pc.x) * w[2][1] + bfhi(pp.x) * w[4][1] + ba[1]);
    ra[2] = bflo(gb.y) * (bflo(pm.y) * w[0][2] + bflo(pc.y) * w[2][2] + bflo(pp.y) * w[4][2] + ba[2]);
    ra[3] = bfhi(gb.y) * (bfhi(pm.y) * w[0][3] + bfhi(pc.y) * w[2][3] + bfhi(pp.y) * w[4][3] + ba[3]);
    rb[0] = bflo(gb.z) * (bflo(pm.z) * w[1][0] + bflo(pc.z) * w[3][0] + bflo(pp.z) * w[5][0] + bb[0]);
    rb[1] = bfhi(gb.z) * (bfhi(pm.z) * w[1][1] + bfhi(pc.z) * w[3][1] + bfhi(pp.z) * w[5][1] + bb[1]);
    rb[2] = bflo(gb.w) * (bflo(pm.w) * w[1][2] + bflo(pc.w) * w[3][2] + bflo(pp.w) * w[5][2] + bb[2]);
    rb[3] = bfhi(gb.w) * (bfhi(pm.w) * w[1][3] + bfhi(pc.w) * w[3][3] + bfhi(pp.w) * w[5][3] + bb[3]);
}
DI void phase_conv(const Ctx& F) {
    const bf16_t* PB = (const bf16_t*)(F.S() + S_PB); const bf16_t* GB = (const bf16_t*)(F.S() + S_GB); bf16_t* A2 = (bf16_t*)(F.S() + S_A2);
    const float* cw = F.in(19); const float* cb = F.in(20);
    const int c0 = (F.tid & 127) * 8;
    f32x4 w[6];
#pragma unroll
    for (int k = 0; k < 3; ++k) { w[2 * k] = *(const f32x4*)(cw + k * 1024 + c0); w[2 * k + 1] = *(const f32x4*)(cw + k * 1024 + c0 + 4); }
    const f32x4 ba = *(const f32x4*)(cb + c0), bb = *(const f32x4*)(cb + c0 + 4);
    const u32x4 zero = {0u, 0u, 0u, 0u};
#define CV_LOAD(P, GBV, run_) do { if ((run_) < NTOK / 8) { const int r0 = (run_) * 8; const int t0 = r0 < NCTX ? (r0 & 255) : ((r0 - NCTX) & 4095); const int tl = r0 < NCTX ? 256 : 4096; \
        P[0] = (t0 > 0) ? *(const u32x4*)(PB + (size_t)(r0 - 1) * DM + c0) : zero; \
        _Pragma("unroll") for (int i = 0; i < 8; ++i) { P[i + 1] = *(const u32x4*)(PB + (size_t)(r0 + i) * DM + c0); GBV[i] = *(const u32x4*)(GB + (size_t)(r0 + i) * DM + c0); } \
        P[9] = (t0 + 8 < tl) ? *(const u32x4*)(PB + (size_t)(r0 + 8) * DM + c0) : zero; } } while (0)
#define CV_PROC(P, GBV, run_) do { if ((run_) < NTOK / 8) { const int r0 = (run_) * 8; \
        _Pragma("unroll") for (int i = 0; i < 8; ++i) { f32x4 ra, rb; conv8(ra, rb, P[i], P[i + 1], P[i + 2], GBV[i], w, ba, bb); *(u32x4*)(A2 + (size_t)(r0 + i) * DM + c0) = pack8(ra, rb); } } } while (0)
    u32x4 pA[10], gA[8], pB[10], gB[8];
    const int step = F.G * 4;
    int run = F.bid * 4 + (F.tid >> 7);
    CV_LOAD(pA, gA, run);
    for (; run < NTOK / 8; run += 2 * step) {
        CV_LOAD(pB, gB, run + step);
        CV_PROC(pA, gA, run);
        CV_LOAD(pA, gA, run + 2 * step);
        CV_PROC(pB, gB, run + step);
    }
#undef CV_LOAD
#undef CV_PROC
}
constexpr int SC_Q = 0, SC_K = 32768, SC_V = 65536, SC_S = 81920, SC_P = 147456, SC_FLAG = SC_P + 64 * 144, SC_END = SC_FLAG + 64;
static_assert(SC_END <= XB_LDS_OFF, "scan LDS");
DI unsigned off_a(unsigned row, unsigned ch) { return 2048u * (row >> 3) + 512u * (ch >> 2) + 64u * (row & 7) + 16u * ((ch & 3) ^ ((0u - (row >> 2)) & 3)); }
#define MFMA16(a, b, c) __builtin_amdgcn_mfma_f32_16x16x32_bf16((a), (b), (c), 0, 0, 0)
DI void tr_read8(s16x4 (&r)[8], unsigned a0, unsigned a1, unsigned a2, unsigned a3, unsigned a4, unsigned a5, unsigned a6, unsigned a7) {
    asm volatile("ds_read_b64_tr_b16 %0, %8\n\tds_read_b64_tr_b16 %1, %9\n\tds_read_b64_tr_b16 %2, %10\n\tds_read_b64_tr_b16 %3, %11\n\t"
                 "ds_read_b64_tr_b16 %4, %12\n\tds_read_b64_tr_b16 %5, %13\n\tds_read_b64_tr_b16 %6, %14\n\tds_read_b64_tr_b16 %7, %15\n\ts_waitcnt lgkmcnt(0)"
                 : "=&v"(r[0]), "=&v"(r[1]), "=&v"(r[2]), "=&v"(r[3]), "=&v"(r[4]), "=&v"(r[5]), "=&v"(r[6]), "=&v"(r[7])
                 : "v"(a0), "v"(a1), "v"(a2), "v"(a3), "v"(a4), "v"(a5), "v"(a6), "v"(a7) : "memory");
}
DI void tr_read4(s16x4 (&r)[4], unsigned a0, unsigned a1, unsigned a2, unsigned a3) {
    asm volatile("ds_read_b64_tr_b16 %0, %4\n\tds_read_b64_tr_b16 %1, %5\n\tds_read_b64_tr_b16 %2, %6\n\tds_read_b64_tr_b16 %3, %7\n\ts_waitcnt lgkmcnt(0)"
                 : "=&v"(r[0]), "=&v"(r[1]), "=&v"(r[2]), "=&v"(r[3]) : "v"(a0), "v"(a1), "v"(a2), "v"(a3) : "memory");
}
template <int OFF> DI void tr_read8i(s16x4 (&r)[8], unsigned b00, unsigned b10, unsigned b01, unsigned b11) {
    asm volatile("ds_read_b64_tr_b16 %0, %8 offset:%12\n\tds_read_b64_tr_b16 %1, %9 offset:%12\n\tds_read_b64_tr_b16 %2, %10 offset:%12\n\tds_read_b64_tr_b16 %3, %11 offset:%12\n\t"
                 "ds_read_b64_tr_b16 %4, %8 offset:%13\n\tds_read_b64_tr_b16 %5, %9 offset:%13\n\tds_read_b64_tr_b16 %6, %10 offset:%13\n\tds_read_b64_tr_b16 %7, %11 offset:%13\n\ts_waitcnt lgkmcnt(0)"
                 : "=&v"(r[0]), "=&v"(r[1]), "=&v"(r[2]), "=&v"(r[3]), "=&v"(r[4]), "=&v"(r[5]), "=&v"(r[6]), "=&v"(r[7])
                 : "v"(b00), "v"(b10), "v"(b01), "v"(b11), "i"(OFF), "i"(OFF + 512) : "memory");
}
template <int OFF> DI void tr_read4i(s16x4 (&r)[4], unsigned b00, unsigned b10, unsigned b01, unsigned b11) {
    asm volatile("ds_read_b64_tr_b16 %0, %4 offset:%8\n\tds_read_b64_tr_b16 %1, %5 offset:%8\n\tds_read_b64_tr_b16 %2, %6 offset:%8\n\tds_read_b64_tr_b16 %3, %7 offset:%8\n\ts_waitcnt lgkmcnt(0)"
                 : "=&v"(r[0]), "=&v"(r[1]), "=&v"(r[2]), "=&v"(r[3]) : "v"(b00), "v"(b10), "v"(b01), "v"(b11), "i"(OFF) : "memory");
}
#define TR_OUT8(r) "=&v"(r[0]), "=&v"(r[1]), "=&v"(r[2]), "=&v"(r[3]), "=&v"(r[4]), "=&v"(r[5]), "=&v"(r[6]), "=&v"(r[7])
#define TR_IO8(r) "+v"(r[0]), "+v"(r[1]), "+v"(r[2]), "+v"(r[3]), "+v"(r[4]), "+v"(r[5]), "+v"(r[6]), "+v"(r[7])
template <int OFF> DI void tr_issue8(s16x4 (&rn)[8], unsigned b00, unsigned b10, unsigned b01, unsigned b11) {
    asm volatile("ds_read_b64_tr_b16 %0, %8 offset:%12\n\tds_read_b64_tr_b16 %1, %9 offset:%12\n\tds_read_b64_tr_b16 %2, %10 offset:%12\n\tds_read_b64_tr_b16 %3, %11 offset:%12\n\t"
                 "ds_read_b64_tr_b16 %4, %8 offset:%13\n\tds_read_b64_tr_b16 %5, %9 offset:%13\n\tds_read_b64_tr_b16 %6, %10 offset:%13\n\tds_read_b64_tr_b16 %7, %11 offset:%13"
                 : TR_OUT8(rn) : "v"(b00), "v"(b10), "v"(b01), "v"(b11), "i"(OFF), "i"(OFF + 512) : "memory");
}
template <int OFF> DI void tr_issue8_wait8(s16x4 (&rn)[8], s16x4 (&ro)[8], unsigned b00, unsigned b10, unsigned b01, unsigned b11) {
    asm volatile("ds_read_b64_tr_b16 %0, %16 offset:%20\n\tds_read_b64_tr_b16 %1, %17 offset:%20\n\tds_read_b64_tr_b16 %2, %18 offset:%20\n\tds_read_b64_tr_b16 %3, %19 offset:%20\n\t"
                 "ds_read_b64_tr_b16 %4, %16 offset:%21\n\tds_read_b64_tr_b16 %5, %17 offset:%21\n\tds_read_b64_tr_b16 %6, %18 offset:%21\n\tds_read_b64_tr_b16 %7, %19 offset:%21\n\ts_waitcnt lgkmcnt(8)"
                 : TR_OUT8(rn), TR_IO8(ro) : "v"(b00), "v"(b10), "v"(b01), "v"(b11), "i"(OFF), "i"(OFF + 512) : "memory");
}
DI void tr_wait0(s16x4 (&ro)[8]) { asm volatile("s_waitcnt lgkmcnt(0)" : TR_IO8(ro) :: "memory"); }
DI bf16x8 cat4(const s16x4& lo, const s16x4& hi) { return __builtin_shufflevector(lo, hi, 0, 1, 2, 3, 4, 5, 6, 7); }
DI int scan_chunk_row(int b, int dir, int step) {
    if (dir == 0) return step < 4 ? b * 256 + step * 64 : NCTX + b * 4096 + (step - 4) * 64;
    return step < 4 ? b * 256 + (3 - step) * 64 : NCTX + b * 4096 + (67 - step) * 64;
}
DI void phase_ret_scan(const Ctx& F, int jl) {
    const bf16_t* QKV = (const bf16_t*)(F.S() + S_QKV); bf16_t* Obuf = (bf16_t*)(F.S() + S_O); float* STATS = (float*)(F.ws + WS_STATS);
    const float* decay = F.in(9) + jl * 8;
    LAS unsigned char* lds = F.lds; const unsigned ldsb = (unsigned)(uintptr_t)lds;
    const int w = F.wave, it = w >> 1, wh = w & 1;
    unsigned pseq = 0u;
    if (F.tid < 8) *(LAS unsigned*)(lds + SC_FLAG + 4 * F.tid) = 0u;
    for (int item = F.bid; item < 256; item += F.G) {
        const int bhx = ((item & 7) << 3) | (item >> 5), b = bhx >> 2, h = bhx & 3, sl = (item >> 3) & 3;
        for (int dir = 0; dir < 2; ++dir) {
            const float x = decay[dir * 4 + h]; const float lg2 = -log1pf(expf(-x)) * 1.4426950408889634f;
            const float gL = exp2f(lg2 * 64.0f);
            f32x4 st[2][8];
#pragma unroll
            for (int dd = 0; dd < 2; ++dd)
#pragma unroll
                for (int et = 0; et < 8; ++et) st[dd][et] = (f32x4){0.f, 0.f, 0.f, 0.f};
            u32x4 qreg[4], kreg[4], vreg[2];
            {   const int rb = scan_chunk_row(b, dir, 0);
                const int srow = 8 * (F.tid >> 6) + ((F.tid >> 2) & 7), sub = (F.tid >> 5) & 1, c4 = F.tid & 3;
#pragma unroll
                for (int i = 0; i < 4; ++i) { const bf16_t* src = QKV + (size_t)(rb + srow) * 4096 + h * 256 + (4 * (sub + 2 * i) + c4) * 8; qreg[i] = *(const u32x4*)src; kreg[i] = *(const u32x4*)(src + 1024); }
#pragma unroll
                for (int i = 0; i < 2; ++i) vreg[i] = *(const u32x4*)(QKV + (size_t)(rb + srow) * 4096 + 2048 + h * 512 + sl * 128 + (4 * (sub + 2 * i) + c4) * 8);
            }
            for (int step = 0; step < 68; ++step) {
                const int rb = scan_chunk_row(b, dir, step);
                int tz = F.tid; asm volatile("" : "+v"(tz));
                const int lane = tz & 63, g = lane >> 4, l15 = lane & 15, qd = l15 >> 2, pp = lane & 3, ph = pp >> 1;
                const int srow = 8 * (tz >> 6) + ((tz >> 2) & 7), sub = (tz >> 5) & 1, c4 = tz & 3;
                const unsigned rowbase = off_a(l15, g);
                unsigned trb[2][2];
#pragma unroll
                for (int t = 0; t < 2; ++t)
#pragma unroll
                    for (int par = 0; par < 2; ++par) trb[t][par] = ldsb + off_a(8 * g + 4 * t + qd, 2 * par + ph) + 8 * (pp & 1);
                const unsigned sdb0 = SC_S + 2048u * ((16 * 2 * w + l15) >> 3) + 64u * (l15 & 7) + 16u * ((g >> 1) ^ (qd & 1)) + 8u * ((g & 1) ^ ((l15 >> 1) & 1));
                const unsigned sdh = ((qd >> 1) ^ qd) & 1; const unsigned sdbp[2] = {sdb0 + 32u * sdh, sdb0 + 32u * (1 - sdh)};
#pragma unroll
                for (int dd = 0; dd < 2; ++dd)
#pragma unroll
                    for (int et = 0; et < 8; ++et) { st[dd][et] *= gL;
                        u32x2 pk; pk.x = cvt_pk_bf16(st[dd][et][0], st[dd][et][1]); pk.y = cvt_pk_bf16(st[dd][et][2], st[dd][et][3]);
                        *(LAS u32x2*)(lds + sdbp[et & 1] + 4096u * dd + 512u * (et >> 1)) = pk; }
                const float vs = exp2f(lg2 * (float)(dir == 0 ? 63 - srow : srow));
#pragma unroll
                for (int i = 0; i < 4; ++i) { const int cb = sub + 2 * i; const unsigned o = (cb >> 2) * 16384 + off_a(srow, 4 * (cb & 3) + c4); *(LAS u32x4*)(lds + SC_Q + o) = qreg[i]; *(LAS u32x4*)(lds + SC_K + o) = kreg[i]; }
#pragma unroll
                for (int i = 0; i < 2; ++i) { const u32x4 v = vreg[i]; u32x4 ks;
                    ks.x = cvt_pk_bf16(bflo(v.x) * vs, bfhi(v.x) * vs); ks.y = cvt_pk_bf16(bflo(v.y) * vs, bfhi(v.y) * vs); ks.z = cvt_pk_bf16(bflo(v.z) * vs, bfhi(v.z) * vs); ks.w = cvt_pk_bf16(bflo(v.w) * vs, bfhi(v.w) * vs);
                    *(LAS u32x4*)(lds + SC_V + off_a(srow, 4 * (sub + 2 * i) + c4)) = ks; }
                __syncthreads();
                if (step + 1 < 68) { const int rn = scan_chunk_row(b, dir, step + 1);
#pragma unroll
                    for (int i = 0; i < 4; ++i) { const bf16_t* src = QKV + (size_t)(rn + srow) * 4096 + h * 256 + (4 * (sub + 2 * i) + c4) * 8; qreg[i] = *(const u32x4*)src; kreg[i] = *(const u32x4*)(src + 1024); }
#pragma unroll
                    for (int i = 0; i < 2; ++i) vreg[i] = *(const u32x4*)(QKV + (size_t)(rn + srow) * 4096 + 2048 + h * 512 + sl * 128 + (4 * (sub + 2 * i) + c4) * 8);
                }
                bf16_t* const op = Obuf + (size_t)(rb + 16 * it + l15) * 2048 + h * 512 + sl * 128 + 64 * wh + 4 * g;
                u32x2 ofw[4];
                if (dir == 1) {
#pragma unroll
                    for (int e4 = 0; e4 < 4; ++e4) ofw[e4] = *(const u32x2*)(op + 16 * e4);
                }
                bf16x8 qf[8]; f32x4 pacc[2]; pacc[0] = (f32x4){0.f, 0.f, 0.f, 0.f}; pacc[1] = pacc[0];
#pragma unroll
                for (int s8 = 0; s8 < 8; ++s8) { const unsigned io = (s8 >> 2) * 16384 + rowbase + 512 * (s8 & 3);
                    qf[s8] = *(const LAS bf16x8*)(lds + SC_Q + io + 4096 * it);
#pragma unroll
                    for (int jj = 0; jj < 2; ++jj) { const bf16x8 kf = *(const LAS bf16x8*)(lds + SC_K + io + 4096 * (2 * wh + jj)); pacc[jj] = MFMA16(kf, qf[s8], pacc[jj]); } }
#pragma unroll
                for (int jj = 0; jj < 2; ++jj) { const int i = 16 * it + l15, j0 = 16 * (2 * wh + jj) + 4 * g; f32x4 pv = pacc[jj];
#pragma unroll
                    for (int r = 0; r < 4; ++r) { const bool keep = (dir == 0) ? (j0 + r <= i) : (j0 + r >= i); pv[r] = keep ? pv[r] : 0.f; }
                    u32x2 pk; pk.x = cvt_pk_bf16(pv[0], pv[1]); pk.y = cvt_pk_bf16(pv[2], pv[3]); *(LAS u32x2*)(lds + SC_P + i * 144 + j0 * 2) = pk; }
                {   ++pseq; asm volatile("" ::: "memory");
                    if (lane == 0) *(volatile LAS unsigned*)(lds + SC_FLAG + 4 * w) = pseq;
                    while ((int)(*(volatile LAS unsigned*)(lds + SC_FLAG + 4 * (w ^ 1)) - pseq) < 0) __builtin_amdgcn_s_sleep(1);
                    asm volatile("" ::: "memory"); }
                f32x4 oacc[4];
#pragma unroll
                for (int e4 = 0; e4 < 4; ++e4) oacc[e4] = (f32x4){0.f, 0.f, 0.f, 0.f};
                {   const unsigned wo = SC_S + 1024u * wh + (((qd >> 1) & 1) ? 8u - 16u * (pp & 1) : 0u);
                    const unsigned s00 = trb[0][0] + wo, s10 = trb[1][0] + wo, s01 = trb[0][1] + wo, s11 = trb[1][1] + wo;
                    const unsigned wv = SC_V + 1024u * wh; const unsigned v00 = trb[0][0] + wv, v10 = trb[1][0] + wv, v01 = trb[0][1] + wv, v11 = trb[1][1] + wv;
                    const unsigned pb = SC_P + (16 * it + l15) * 144 + 16 * g;
                    const bf16x8 pf0 = *(const LAS bf16x8*)(lds + pb), pf1 = *(const LAS bf16x8*)(lds + pb + 64);
                    asm volatile("s_waitcnt lgkmcnt(0)" ::: "memory");
                    s16x4 ra[8], rb[8];
#define O_MMA(R, BF) { _Pragma("unroll") for (int e4 = 0; e4 < 4; ++e4) oacc[e4] = MFMA16(cat4(R[2 * e4], R[2 * e4 + 1]), BF, oacc[e4]); }
                    tr_issue8<0>(ra, s00, s10, s01, s11);
                    tr_issue8_wait8<8192 * 1>(rb, ra, s00, s10, s01, s11); O_MMA(ra, qf[0])
                    tr_issue8_wait8<8192 * 2>(ra, rb, s00, s10, s01, s11); O_MMA(rb, qf[1])
                    tr_issue8_wait8<8192 * 3>(rb, ra, s00, s10, s01, s11); O_MMA(ra, qf[2])
                    tr_issue8_wait8<8192 * 4>(ra, rb, s00, s10, s01, s11); O_MMA(rb, qf[3])
                    tr_issue8_wait8<8192 * 5>(rb, ra, s00, s10, s01, s11); O_MMA(ra, qf[4])
                    tr_issue8_wait8<8192 * 6>(ra, rb, s00, s10, s01, s11); O_MMA(rb, qf[5])
                    tr_issue8_wait8<8192 * 7>(rb, ra, s00, s10, s01, s11); O_MMA(ra, qf[6])
                    tr_issue8_wait8<0>(ra, rb, v00, v10, v01, v11);        O_MMA(rb, qf[7])
                    tr_issue8_wait8<8192>(rb, ra, v00, v10, v01, v11);     O_MMA(ra, pf0)
                    tr_wait0(rb);                                           O_MMA(rb, pf1)
#undef O_MMA
                }
                {   const int i = 16 * it + l15; const float rs = exp2f(lg2 * (float)(dir == 0 ? i - 63 : -i)); float s1 = 0.f, s2 = 0.f;
#pragma unroll
                    for (int e4 = 0; e4 < 4; ++e4) { f32x4 v = oacc[e4] * rs;
                        if (dir == 1) { v[0] += bflo(ofw[e4].x); v[1] += bfhi(ofw[e4].x); v[2] += bflo(ofw[e4].y); v[3] += bfhi(ofw[e4].y); }
                        u32x2 pk; pk.x = cvt_pk_bf16(v[0], v[1]); pk.y = cvt_pk_bf16(v[2], v[3]); *(u32x2*)(op + 16 * e4) = pk;
                        const float a0 = bflo(pk.x), a1 = bfhi(pk.x), a2 = bflo(pk.y), a3 = bfhi(pk.y); s1 += (a0 + a1) + (a2 + a3); s2 += (a0 * a0 + a1 * a1) + (a2 * a2 + a3 * a3); }
                    if (dir == 1) {
                        s1 += __shfl_xor(s1, 16, 64); s2 += __shfl_xor(s2, 16, 64); s1 += __shfl_xor(s1, 32, 64); s2 += __shfl_xor(s2, 32, 64);
                        if (g == 0) { float* sp = STATS + ((size_t)(rb + i) * 4 + h) * 16 + (sl * 2 + wh) * 2; *(f32x2*)sp = (f32x2){s1, s2}; }
                    }
                }
                {   const unsigned ko = SC_K + (w >> 2) * 16384 + 512u * (w & 3); const unsigned k00 = trb[0][0] + ko, k10 = trb[1][0] + ko, k01 = trb[0][1] + ko, k11 = trb[1][1] + ko;
                    const unsigned v00 = trb[0][0] + SC_V, v10 = trb[1][0] + SC_V, v01 = trb[0][1] + SC_V, v11 = trb[1][1] + SC_V;
                    s16x4 kr[8], ra[8], rb[8];
                    asm volatile("ds_read_b64_tr_b16 %0, %8\n\tds_read_b64_tr_b16 %1, %9\n\tds_read_b64_tr_b16 %2, %10\n\tds_read_b64_tr_b16 %3, %11\n\t"
                                 "ds_read_b64_tr_b16 %4, %8 offset:8192\n\tds_read_b64_tr_b16 %5, %9 offset:8192\n\tds_read_b64_tr_b16 %6, %10 offset:8192\n\tds_read_b64_tr_b16 %7, %11 offset:8192"
                                 : TR_OUT8(kr) : "v"(k00), "v"(k10), "v"(k01), "v"(k11) : "memory");
                    tr_issue8_wait8<0>(ra, kr, v00, v10, v01, v11);
                    const bf16x8 kf00 = cat4(kr[0], kr[1]), kf01 = cat4(kr[2], kr[3]), kf10 = cat4(kr[4], kr[5]), kf11 = cat4(kr[6], kr[7]);
#define S_MMA(R, EB, KA, KB) { _Pragma("unroll") for (int e4 = 0; e4 < 4; ++e4) { const bf16x8 vf = cat4(R[2 * e4], R[2 * e4 + 1]); \
                        st[0][4 * (EB) + e4] = MFMA16(vf, KA, st[0][4 * (EB) + e4]); st[1][4 * (EB) + e4] = MFMA16(vf, KB, st[1][4 * (EB) + e4]); } }
                    tr_issue8_wait8<1024>(rb, ra, v00, v10, v01, v11);          S_MMA(ra, 0, kf00, kf01)
                    tr_issue8_wait8<8192>(ra, rb, v00, v10, v01, v11);          S_MMA(rb, 1, kf00, kf01)
                    tr_issue8_wait8<8192 + 1024>(rb, ra, v00, v10, v01, v11);   S_MMA(ra, 0, kf10, kf11)
                    tr_wait0(rb);                                                S_MMA(rb, 1, kf10, kf11)
#undef S_MMA
                }
                __syncthreads();
            }
        }
    }
}
namespace att {
constexpr int DQK = 192, DV = 128, NW = 8, QBLK = 32, KVBLK = 64;
constexpr float SCALE = 0.07216878364870322f;
constexpr float THR = 8.f;
constexpr int LDQ = 1536, LDK = 192, LDV = 128, LDO = 1024;
constexpr int KROWB = 400;
constexpr int SHM_V = KVBLK * DV * 2, SHM_K = KVBLK * KROWB, SHM_ATTN = 2 * SHM_V + 2 * SHM_K + NW * 64 * 4;
#define KSWZ(row, colB) ((row) * KROWB + (colB))
#define SBAR() __builtin_amdgcn_sched_barrier(0)
DI int crow(int r, int hi) { return (r & 3) + 8 * (r >> 2) + 4 * hi; }
DI unsigned cvtpk(float lo, float hi) { unsigned r; asm volatile("v_cvt_pk_bf16_f32 %0, %1, %2" : "=v"(r) : "v"(lo), "v"(hi)); return r; }
DI void partialSM(f32x16& p0, f32x16& p1, float& m_reg, float& alpha, f32x16& minit, bool first) {
  constexpr float THRL = THR * 1.4426950408889634f;
  float pmax = p0[0];
#pragma unroll
  for (int r = 1; r < 16; ++r) pmax = fmaxf(pmax, p0[r]);
#pragma unroll
  for (int r = 0; r < 16; ++r) pmax = fmaxf(pmax, p1[r]);
  { auto rr = __builtin_amdgcn_permlane32_swap(__float_as_uint(pmax), __float_as_uint(pmax), false, false);
    pmax = fmaxf(__uint_as_float(rr[0]), __uint_as_float(rr[1])); }
  if (__builtin_expect(!first && __all(pmax <= THRL), 1)) { alpha = 1.f; }
  else { const float d = first ? pmax : fmaxf(pmax, 0.f);
    alpha = first ? 1.f : __builtin_amdgcn_exp2f(-d); m_reg += d;
#pragma unroll
    for (int r = 0; r < 16; ++r) { p0[r] -= d; p1[r] -= d; minit[r] = -m_reg; } }
#pragma unroll
  for (int r = 0; r < 16; ++r) p0[r] = __builtin_amdgcn_exp2f(p0[r]);
}
DI void finishSM(f32x16& p0, f32x16& p1, float alpha, float& l_reg, bf16x8& pa0, bf16x8& pa1, bf16x8& pa2, bf16x8& pa3) {
#pragma unroll
  for (int r = 0; r < 16; ++r) p1[r] = __builtin_amdgcn_exp2f(p1[r]);
  float ps = 0;
#pragma unroll
  for (int r = 0; r < 16; ++r) ps += p0[r];
#pragma unroll
  for (int r = 0; r < 16; ++r) ps += p1[r];
  { auto rr = __builtin_amdgcn_permlane32_swap(__float_as_uint(ps), __float_as_uint(ps), false, false);
    ps = __uint_as_float(rr[0]) + __uint_as_float(rr[1]); }
  l_reg = l_reg * alpha + ps;
#define PK4(P, BASE, OUT) do { unsigned a0 = cvtpk(P[BASE + 0], P[BASE + 1]), a1 = cvtpk(P[BASE + 2], P[BASE + 3]);   \
    unsigned b0 = cvtpk(P[BASE + 4], P[BASE + 5]), b1 = cvtpk(P[BASE + 6], P[BASE + 7]);                              \
    auto r0 = __builtin_amdgcn_permlane32_swap(a0, b0, false, false); auto r1 = __builtin_amdgcn_permlane32_swap(a1, b1, false, false); \
    u32x4 w = {r0[0], r1[0], r0[1], r1[1]}; OUT = *reinterpret_cast<bf16x8*>(&w); } while (0)
  PK4(p0, 0, pa0); PK4(p0, 8, pa1); PK4(p1, 0, pa2); PK4(p1, 8, pa3);
#undef PK4
}
DI void qkt(f32x16& p0, f32x16& p1, const LAS char* Ks, const bf16x8 (&qr)[12], int r32, int hi, const f32x16& minit) {
  p0 = minit; p1 = minit;
#pragma unroll
  for (int d0 = 0; d0 < 12; ++d0) { const int cb = (d0 * 16 + hi * 8) * 2;
    const bf16x8 b0 = *reinterpret_cast<const LAS bf16x8*>(Ks + KSWZ(r32, cb));
    const bf16x8 b1 = *reinterpret_cast<const LAS bf16x8*>(Ks + KSWZ(32 + r32, cb));
    p0 = __builtin_amdgcn_mfma_f32_32x32x16_bf16(b0, qr[d0], p0, 0, 0, 0);
    p1 = __builtin_amdgcn_mfma_f32_32x32x16_bf16(b1, qr[d0], p1, 0, 0, 0); }
}
DI int v_st(int k, int c) { const int kk = (k & ~0xC) | ((k & 4) << 1) | ((k & 8) >> 1); return ((kk >> 3) * 4 + (c >> 5)) * 512 + ((kk & 7) * 32 + (c & 31)) * 2; }
DI int v_rd_base(int lane) { return ((lane & 3) << 3) | (((lane >> 2) & 3) << 6) | (((lane >> 4) & 1) << 5) | (((lane >> 5) & 1) << 8); }
constexpr int v_rd_off(int d0, int ks, int half) { return d0 * 512 + ks * 4096 + half * 2048; }
template <int OFF> DI s16x4 tr_read(int vb) { s16x4 r; asm volatile("ds_read_b64_tr_b16 %0, %1 offset:%2" : "=&v"(r) : "v"(vb), "i"(OFF) : "memory"); return r; }
template <int D0> DI void pv_one(f32x16& od, int vb, bf16x8 pa0, bf16x8 pa1, bf16x8 pa2, bf16x8 pa3) {
  const s16x4 l0 = tr_read<v_rd_off(D0, 0, 0)>(vb), h0 = tr_read<v_rd_off(D0, 0, 1)>(vb), l1 = tr_read<v_rd_off(D0, 1, 0)>(vb), h1 = tr_read<v_rd_off(D0, 1, 1)>(vb);
  const s16x4 l2 = tr_read<v_rd_off(D0, 2, 0)>(vb), h2 = tr_read<v_rd_off(D0, 2, 1)>(vb), l3 = tr_read<v_rd_off(D0, 3, 0)>(vb), h3 = tr_read<v_rd_off(D0, 3, 1)>(vb);
  asm volatile("s_waitcnt lgkmcnt(0)" ::: "memory"); SBAR();
#define PK(L, H) (bf16x8){L[0], L[1], L[2], L[3], H[0], H[1], H[2], H[3]}
  od = __builtin_amdgcn_mfma_f32_32x32x16_bf16(pa0, PK(l0, h0), od, 0, 0, 0);
  od = __builtin_amdgcn_mfma_f32_32x32x16_bf16(pa1, PK(l1, h1), od, 0, 0, 0);
  od = __builtin_amdgcn_mfma_f32_32x32x16_bf16(pa2, PK(l2, h2), od, 0, 0, 0);
  od = __builtin_amdgcn_mfma_f32_32x32x16_bf16(pa3, PK(l3, h3), od, 0, 0, 0);
#undef PK
}
DI void pv_d0(f32x16 (&o)[4], int vb, bf16x8 pa0, bf16x8 pa1, bf16x8 pa2, bf16x8 pa3) {
  pv_one<0>(o[0], vb, pa0, pa1, pa2, pa3); pv_one<1>(o[1], vb, pa0, pa1, pa2, pa3); pv_one<2>(o[2], vb, pa0, pa1, pa2, pa3); pv_one<3>(o[3], vb, pa0, pa1, pa2, pa3);
}
DI void rope8(bf16x8& a, bf16x8& b, const f32x4& c0, const f32x4& c1, const f32x4& s0, const f32x4& s1) {
  float x1[8], x2[8];
#pragma unroll
  for (int e = 0; e < 8; ++e) { x1[e] = bf2f((unsigned short)a[e]); x2[e] = bf2f((unsigned short)b[e]); }
  float o1[8], o2[8];
#pragma unroll
  for (int e = 0; e < 8; ++e) { const float c = e < 4 ? c0[e & 3] : c1[e & 3], s = e < 4 ? s0[e & 3] : s1[e & 3]; o1[e] = x1[e] * c - x2[e] * s; o2[e] = x1[e] * s + x2[e] * c; }
  u32x4 wa = {cvtpk(o1[0], o1[1]), cvtpk(o1[2], o1[3]), cvtpk(o1[4], o1[5]), cvtpk(o1[6], o1[7])}, wb = {cvtpk(o2[0], o2[1]), cvtpk(o2[2], o2[3]), cvtpk(o2[4], o2[5]), cvtpk(o2[6], o2[7])};
  a = *reinterpret_cast<bf16x8*>(&wa); b = *reinterpret_cast<bf16x8*>(&wb);
}
DI void attn_body(const bf16_t* __restrict__ Qb, const bf16_t* __restrict__ Kh, const bf16_t* __restrict__ Vh, bf16_t* __restrict__ Ob, int seq, int t0,
                  const float* __restrict__ MC, const float* __restrict__ MS, LAS char* lds, int wave_id) {
  int tid_l = lane_id_fresh(); asm volatile("" : "+v"(tid_l)); tid_l += 64 * wave_id;
  const int tid = tid_l, wid = tid >> 6, lane = tid & 63, r32 = lane & 31, hi = lane >> 5;
  LAS char* V_lds = lds; LAS char* K_lds = lds + 2 * SHM_V;
  LAS float* ws = (LAS float*)(lds + 2 * SHM_V + 2 * SHM_K) + wid * 64; LAS float* li_l = ws; LAS float* al_l = ws + 32;
  float m_reg = 0.f, l_reg = 0; f32x16 o[4] = {}; bf16x8 qr[12]; f32x16 minit = {};
  const int sr = tid >> 4, sc = (tid & 15) * 8, vst0 = v_st(sr, sc), vst1 = v_st(32 + sr, sc);
  int krow[3], kcb[3];
#pragma unroll
  for (int i = 0; i < 3; ++i) { const int id = tid + 512 * i; krow[i] = id / 24; kcb[i] = (id - krow[i] * 24) * 16; }
  const int vb0 = (int)(uintptr_t)V_lds + v_rd_base(lane);
  u32x4 vs0, vs1, ks0, ks1, ks2;
#define SLOAD(k0) do { vs0 = *(const u32x4*)(Vh + (long)((k0) + sr) * LDV + sc); vs1 = *(const u32x4*)(Vh + (long)((k0) + 32 + sr) * LDV + sc); \
    ks0 = *(const u32x4*)((const char*)(Kh + (long)((k0) + krow[0]) * LDK) + kcb[0]); ks1 = *(const u32x4*)((const char*)(Kh + (long)((k0) + krow[1]) * LDK) + kcb[1]); \
    ks2 = *(const u32x4*)((const char*)(Kh + (long)((k0) + krow[2]) * LDK) + kcb[2]); } while (0)
#define SWRITE(b) do { *(LAS u32x4*)(V_lds + (b) * SHM_V + vst0) = vs0; *(LAS u32x4*)(V_lds + (b) * SHM_V + vst1) = vs1; \
    *(LAS u32x4*)(K_lds + (b) * SHM_K + KSWZ(krow[0], kcb[0])) = ks0; *(LAS u32x4*)(K_lds + (b) * SHM_K + KSWZ(krow[1], kcb[1])) = ks1; \
    *(LAS u32x4*)(K_lds + (b) * SHM_K + KSWZ(krow[2], kcb[2])) = ks2; } while (0)
#define SWAIT() asm volatile("s_waitcnt vmcnt(0)" ::: "memory")
#define RESC(a) do { if (__any((a) < 1.f)) { if (hi == 0) al_l[r32] = (a); asm volatile("s_waitcnt lgkmcnt(0)" ::: "memory"); \
    _Pragma("unroll") for (int d = 0; d < 4; ++d) _Pragma("unroll") for (int r = 0; r < 16; ++r) o[d][r] *= al_l[crow(r, hi)]; } } while (0)
  f32x16 p0, p1; float al; bf16x8 pa0, pa1, pa2, pa3; const int NT = seq / KVBLK;
  {
    const u32x4 t0v0 = *(const u32x4*)(Vh + (long)(sr) * LDV + sc), t0v1 = *(const u32x4*)(Vh + (long)(32 + sr) * LDV + sc);
    const u32x4 t0k0 = *(const u32x4*)((const char*)(Kh + (long)(krow[0]) * LDK) + kcb[0]), t0k1 = *(const u32x4*)((const char*)(Kh + (long)(krow[1]) * LDK) + kcb[1]), t0k2 = *(const u32x4*)((const char*)(Kh + (long)(krow[2]) * LDK) + kcb[2]);
    SLOAD(KVBLK);
    const bf16_t* Qw = Qb + (long)(wid * QBLK + r32) * LDQ + hi * 8;
  #pragma unroll
    for (int d0 = 0; d0 < 12; ++d0) qr[d0] = *reinterpret_cast<const bf16x8*>(Qw + d0 * 16);
    if (t0 >= 0) { const int t = t0 + wid * QBLK + r32; const int pr = t >> 6, pc = t & 63;
      const f32x4 cr0 = *(const f32x4*)(MC + pr * 16 + hi * 8), cr1 = *(const f32x4*)(MC + pr * 16 + hi * 8 + 4), sr0 = *(const f32x4*)(MS + pr * 16 + hi * 8), sr1 = *(const f32x4*)(MS + pr * 16 + hi * 8 + 4);
      const f32x4 cc0 = *(const f32x4*)(MC + pc * 16 + hi * 8), cc1 = *(const f32x4*)(MC + pc * 16 + hi * 8 + 4), sc0 = *(const f32x4*)(MS + pc * 16 + hi * 8), sc1 = *(const f32x4*)(MS + pc * 16 + hi * 8 + 4);
      rope8(qr[8], qr[10], cr0, cr1, sr0, sr1); rope8(qr[9], qr[11], cc0, cc1, sc0, sc1); }
    SWAIT();
    *(LAS u32x4*)(V_lds + vst0) = t0v0; *(LAS u32x4*)(V_lds + vst1) = t0v1;
    *(LAS u32x4*)(K_lds + KSWZ(krow[0], kcb[0])) = t0k0; *(LAS u32x4*)(K_lds + KSWZ(krow[1], kcb[1])) = t0k1; *(LAS u32x4*)(K_lds + KSWZ(krow[2], kcb[2])) = t0k2;
    SWRITE(1); __syncthreads(); }
#pragma unroll 1
  for (int j = 0; j < NT; ++j) {
    const int buf = j & 1;
    if (j + 2 < NT) SLOAD((j + 2) * KVBLK);
    SBAR(); qkt(p0, p1, K_lds + buf * SHM_K, qr, r32, hi, minit);
    partialSM(p0, p1, m_reg, al, minit, j == 0);
    RESC(al);
    finishSM(p0, p1, al, l_reg, pa0, pa1, pa2, pa3); SBAR();
    pv_d0(o, vb0 + buf * SHM_V, pa0, pa1, pa2, pa3);
    __syncthreads();
    if (j + 2 < NT) { SWAIT(); SWRITE(buf); }
  }
  if (hi == 0) li_l[r32] = l_reg; asm volatile("s_waitcnt lgkmcnt(0)" ::: "memory");
  float rli[16];
#pragma unroll
  for (int r = 0; r < 16; ++r) rli[r] = __builtin_amdgcn_rcpf(li_l[crow(r, hi)]);
  bf16_t* Ow = Ob + (long)(wid * QBLK) * LDO;
#pragma unroll
  for (int r = 0; r < 16; ++r) { const int orow = crow(r, hi);
#pragma unroll
    for (int d0 = 0; d0 < 4; ++d0) Ow[(long)orow * LDO + d0 * 32 + r32] = (bf16_t)(cvtpk(o[d0][r] * rli[r], 0.f) & 0xffffu); }
#undef SLOAD
#undef SWRITE
#undef SWAIT
#undef RESC
}
}

DI void phase_mla_attn(const Ctx& F) {
    const bf16_t* MQ = (const bf16_t*)(F.S() + S_MQ); const bf16_t* KK = (const bf16_t*)(F.S() + S_KK); const bf16_t* VV = (const bf16_t*)(F.S() + S_VV); bf16_t* AO = (bf16_t*)(F.S() + S_AO);
    const int c = F.bid, xcd = c & 7, jx = c >> 3;
    const int nlat = NB * 8 * 16, nctx = NB * 8;
#pragma unroll 1
    for (int i = 0; ; ++i) {
        int u = i * F.G + c;
        if (u >= nlat + nctx) break;
        int bh, seq, t0; size_t qrow;
        if (u < nlat) {
            if (F.G == 256) u = (((i * 2 + (jx >> 4)) * 8 + xcd) << 4) | (jx & 15);
            bh = u >> 4; const int qb = u & 15; qrow = (size_t)NCTX + (size_t)(bh >> 3) * 4096 + qb * 256; seq = KVLEN; t0 = qb * 256;
        } else { bh = u - nlat; qrow = (size_t)(bh >> 3) * 256; seq = CTXL; t0 = -1; }
        const int h = bh & 7;
        __syncthreads();
        att::attn_body(MQ + qrow * 1536 + h * 192, KK + (size_t)bh * KVLEN * 192, VV + (size_t)bh * KVLEN * 128, AO + qrow * 1024 + h * 128, seq, t0, F.MC(), F.MS(), (LAS char*)F.lds, F.wave);
    }
}
using pg8::Gemm; using pg8::StaticOrder; using pg8::GroupedOrder; using pg8::gemm_phase;
#define GEMM_LDS(F) ((LAS unsigned char*)(F).lds)
template <class Epi> DI void run_gemm(const Ctx& F, const bf16_t* A, const bf16_t* Bt, int M, int N, int K, const Epi& E, int pm0 = 0, bool rev = false) {
    Gemm g{A, Bt, M, N, K}; StaticOrder S; S.init(M - pm0 * 256, N, F.G, rev ? F.G - 1 - F.bid : F.bid); S.pm0 = pm0;
    gemm_phase<Epi, StaticOrder, false>(GEMM_LDS(F), g, S, E, nullptr, F.wave);
}
constexpr int MOE_TAB = 131072;
constexpr int MOE_ROWTAB = MOE_TAB + 4096;
template <class Epi, bool GATHER> DI void run_moe_gemm(const Ctx& F, int l, const bf16_t* A, const bf16_t* Bt, int K, const Epi& E) {
    LAS int* ps = (LAS int*)(F.lds + MOE_TAB); LAS int* cnt = (LAS int*)(F.lds + MOE_TAB + 256); LAS int* tile_e = (LAS int*)(F.lds + MOE_TAB + 512); LAS int* rowtab = (LAS int*)(F.lds + MOE_ROWTAB);
    moe_prefix(F, l, ps, cnt);
    const int ntile = ps[32] >> 8;
    if (F.tid < 32) { const int e = F.tid; for (int t = ps[e] >> 8; t < (ps[e + 1] >> 8); ++t) tile_e[t] = e; }
    {
        const int* rowtok = (const int*)(F.ws + WS_ROWTOK); const float* roww = (const float*)(F.ws + WS_ROWW); LAS float* wtab = (LAS float*)(F.lds + MOE_ROWTAB + 10240);
        const GroupedOrder S0{ntile, 4, F.G, F.bid, tile_e, rowtab};
        if ((GATHER || F.G == 256) && F.tid < 256) {
            int sv[10]; float wv[10]; bool ok[10];
#pragma unroll
            for (int ui = 0; ui < 10; ++ui) { int t, pl; ok[ui] = S0.unit_of(ui, t, pl); const int tt = ok[ui] ? t : 0; sv[ui] = rowtok[tt * 256 + F.tid]; wv[ui] = GATHER ? 0.f : roww[tt * 256 + F.tid]; }
#pragma unroll
            for (int ui = 0; ui < 10; ++ui) if (ok[ui]) {
                if (GATHER) rowtab[ui * 256 + F.tid] = sv[ui] >= 0 ? (sv[ui] >> 1) : 0;
                else { rowtab[ui * 256 + F.tid] = sv[ui]; wtab[ui * 256 + F.tid] = wv[ui] * (64.0f / (FP8_SH * FP8_SW)); } }
        }
    }
    __syncthreads();
    Gemm g{A, Bt, MAXROWS, 1024, K / 2}; GroupedOrder S{ntile, 4, F.G, F.bid, tile_e, rowtab};
    gemm_phase<Epi, GroupedOrder, false, GATHER, true>(GEMM_LDS(F), g, S, E, nullptr, F.wave);
}

__global__ void __launch_bounds__(NTHREADS, 2) mega_fwd(Params prm) {
    extern __shared__ __attribute__((aligned(16))) unsigned char lds_raw[];
    Ctx F; F.lds = (LAS unsigned char*)lds_raw; F.tid = threadIdx.x; F.lane = F.tid & 63; F.wave = __builtin_amdgcn_readfirstlane(F.tid >> 6); F.G = gridDim.x; F.bid = blockIdx.x; F.ws = F.wsp();
    if (F.tid == 0) { *(LAS u32x4*)(F.lds + XB_LDS_OFF) = (u32x4){0u, 0u, 0u, 0u}; *(LAS u32x4*)(F.lds + XB_LDS_OFF - 16) = (u32x4){0u, 0u, 0u, 0u}; }
    __syncthreads();
    XcdBarrier bar = xcd_barrier_post((unsigned*)(F.ws + WS_CTL), (volatile LAS unsigned*)(F.lds + XB_LDS_OFF));
#ifndef PROBE_GROUP
#define PROBE_GROUP 0
#endif
#define PH_T0() do { if (PROBE_GROUP != 0 && blockIdx.x == 0 && threadIdx.x == 0) *(LAS unsigned long long*)(F.lds + XB_LDS_OFF - 16) = __builtin_amdgcn_s_memrealtime(); } while (0)
#define PH_T1(grp) do { if (PROBE_GROUP != 0 && ((grp) == PROBE_GROUP || (PROBE_GROUP == 99 && ((grp) == 4 || (grp) == 5 || (grp) == 7 || (grp) == 8 || (grp) == 9))) && blockIdx.x == 0 && threadIdx.x == 0) *(LAS unsigned long long*)(F.lds + XB_LDS_OFF - 8) += __builtin_amdgcn_s_memrealtime() - *(LAS unsigned long long*)(F.lds + XB_LDS_OFF - 16); } while (0)
#define GRID_BAR() do { __syncthreads(); XcdBarrier b2 = bar; asm volatile("" : "+s"(b2.bar), "+s"(b2.x)); b2.bar = (unsigned*)(__attribute__((address_space(1))) unsigned*)b2.bar; xcd_barrier(b2); } while (0)

#define PHASE(grp, ...) do { PH_T0(); __VA_ARGS__; GRID_BAR(); PH_T1(grp); } while (0)
    PHASE(8, phase_mod(F.fresh()); phase_tables(F.fresh()); phase_wconv(F.fresh(), 0));
    {   LAS unsigned* xw = (LAS unsigned*)(F.lds + XB_LDS_OFF);
        if (threadIdx.x == 0) { unsigned* cen = (unsigned*)(F.ws + WS_CTL); unsigned nx = 0, myidx = 0, ok = 1; const unsigned per = (unsigned)F.G >> 3;
            for (unsigned j = 0; j < 16; ++j) { const unsigned c = xb_ld(&cen[XB_XCNT(j)]); if (c) { if (j == bar.x) myidx = nx; ++nx; if (c != per) ok = 0; } }
            const unsigned rank = xw[2]; ok = ok && (nx == 8u) && (per * 8u == (unsigned)F.G) && (rank < per);
            xw[3] = ok ? (rank * 8u + myidx) : (unsigned)blockIdx.x; }
        __syncthreads();
        F.bid = __builtin_amdgcn_readfirstlane((int)xw[3]);
    }
    PHASE(8, phase_u0(F.fresh()));

#pragma unroll 1
    for (int l = 0; l < DEPTH; ++l) {
        const int kind = l % 3, jl = l / 3; const bool lastl = (l == DEPTH - 1);
        if (kind == 0) {
            PHASE(1, run_gemm(F.fresh(), F.U(), F.WMIX() + WM_RET_IN, NTOK, 4096, 1024, pg8::EpiRetQKV{(bf16_t*)(F.S() + S_QKV), F.RC(), F.RS()}));
            PHASE(2, phase_ret_scan(F.fresh(), jl));
            PHASE(2, phase_stats_fin(F.fresh()));
            PHASE(1, run_gemm(F.fresh(), F.U(), F.WMIX() + WM_RET_IN + (size_t)4096 * 1024, NTOK, 2048, 1024, pg8::EpiRetGate{(bf16_t*)(F.S() + S_O), (const float*)(F.ws + WS_MR), F.in(10) + (size_t)jl * 2048}, lastl ? 16 : 0));
            PHASE(1, run_gemm(F.fresh(), (const bf16_t*)(F.S() + S_O), F.WMIX() + WM_RET_OUT, NTOK, 1024, 2048, pg8::EpiBf16Plain{(bf16_t*)(F.S() + S_QKV), 1024}, lastl ? 16 : 0));
        } else if (kind == 1) {
            PHASE(1, run_gemm(F.fresh(), F.U(), F.WMIX() + WM_MLA_DOWN, NTOK, 768, 1024, pg8::EpiBf16Plain{(bf16_t*)(F.S() + S_DWN), 768}));
            PHASE(9, phase_mla_prep(F.fresh()));
            PHASE(1, run_gemm(F.fresh(), (const bf16_t*)(F.S() + S_DQ), F.WMIX() + WM_MLA_UQ, NTOK, 1536, 384, pg8::EpiBf16Plain{(bf16_t*)(F.S() + S_MQ), 1536});
                     run_gemm(F.fresh(), (const bf16_t*)(F.S() + S_DKV), F.WMIX() + WM_MLA_UKV, NTOK, 2048, 256, pg8::EpiMlaKV{(bf16_t*)(F.S() + S_KK), (bf16_t*)(F.S() + S_VV)}, 0, true));
            PHASE(3, phase_mla_attn(F.fresh()));
            PHASE(1, run_gemm(F.fresh(), (const bf16_t*)(F.S() + S_AO), F.WMIX() + WM_MLA_OUT, NTOK, 1024, 1024, pg8::EpiBf16Plain{(bf16_t*)(F.S() + S_MQ), 1024}));
        } else {
            PHASE(1, run_gemm(F.fresh(), F.U(), F.WMIX() + WM_CONV_IN, NTOK, 3072, 1024, pg8::EpiConvIn{(bf16_t*)(F.S() + S_GB), (bf16_t*)(F.S() + S_PB)}));
            PHASE(9, phase_conv(F.fresh()));
            PHASE(1, run_gemm(F.fresh(), (const bf16_t*)(F.S() + S_A2), F.WMIX() + WM_CONV_OUT, NTOK, 1024, 1024, pg8::EpiBf16Plain{(bf16_t*)(F.S() + S_PB), 1024}));
        }
        const int r0 = lastl ? NCTX : 0, rpb = lastl ? NLAT / 256 : NTOK / 256;
        PHASE(4, phase_ln1_router(F.fresh(), l, (const bf16_t*)(F.S() + (kind == 0 ? S_QKV : (kind == 1 ? S_MQ : S_PB))), r0, rpb));
        PHASE(5, phase_moe_pos(F.fresh(), l, r0));
        PHASE(6, run_moe_gemm<pg8::EpiMoe1, true>(F.fresh(), l, F.U(), F.W13(), 1024, pg8::EpiMoe1{(unsigned char*)(F.S() + S_HDN)}));
        PHASE(6, run_moe_gemm<pg8::EpiMoe2, false>(F.fresh(), l, (const bf16_t*)(F.S() + S_HDN), F.W2(), 512, pg8::EpiMoe2{(unsigned char*)(F.S() + S_YS), (const int*)(F.ws + WS_ROWTOK), (const float*)(F.ws + WS_ROWW), (const LAS int*)(F.lds + MOE_ROWTAB), (const LAS float*)(F.lds + MOE_ROWTAB + 10240), F.G == 256}));
        PH_T0();
        phase_ln2(F.fresh(), l, r0, rpb);
        if (l + 1 < DEPTH) { phase_wconv(F.fresh(), l + 1); GRID_BAR(); }
        PH_T1(7);
    }
    if (PROBE_GROUP != 0 && blockIdx.x == 0 && threadIdx.x == 0) {
        const unsigned long long t0 = __builtin_amdgcn_s_memrealtime(), dt = 4ull * *(LAS unsigned long long*)(F.lds + XB_LDS_OFF - 8);
        while (__builtin_amdgcn_s_memrealtime() - t0 < dt) __builtin_amdgcn_s_sleep(8);
    }
}

extern "C" void kernel_launch(void* const* d_in, const int* in_sizes, int n_in, void* d_out, int out_size, void* d_ws, size_t ws_size, hipStream_t stream) {
    static int grid = 0;
    if (grid == 0) {
        if (n_in != 29 || out_size != NLAT * DM || ws_size < WS_END) { fprintf(stderr, "kernel_launch: unexpected shapes: n_in %d out %d ws %zu (need %zu)\n", n_in, out_size, ws_size, (size_t)WS_END); grid = -1; return; }
        int dev = 0, cus = 0, per_cu = 0;
        if (hipGetDevice(&dev) != hipSuccess || hipDeviceGetAttribute(&cus, hipDeviceAttributeMultiprocessorCount, dev) != hipSuccess) { grid = -1; return; }
        if (hipFuncSetAttribute((const void*)mega_fwd, hipFuncAttributeMaxDynamicSharedMemorySize, LDS_BYTES) != hipSuccess) { fprintf(stderr, "kernel_launch: hipFuncSetAttribute failed\n"); grid = -1; return; }
        if (hipOccupancyMaxActiveBlocksPerMultiprocessor(&per_cu, (const void*)mega_fwd, NTHREADS, LDS_BYTES) != hipSuccess || per_cu < 1) { fprintf(stderr, "kernel_launch: occupancy query says %d\n", per_cu); }
        (void)hipGetLastError();
        grid = cus;
    }
    if (grid < 0) return;
    (void)in_sizes;
    hipMemsetAsync((char*)d_ws + WS_CTL, 0, CTL_BYTES, stream);
    Params p{};
    for (int i = 0; i < 29; ++i) p.in[i] = (const float*)d_in[i];
    p.out = (float*)d_out; p.ws = (unsigned char*)d_ws;
    hipLaunchKernelGGL(mega_fwd, dim3(grid), dim3(NTHREADS), LDS_BYTES, stream, p);
}
```
